# Optimizing an MI355X kernel written in HIP

```python
import math
import jax, jax.numpy as jnp
from jax import lax
import numpy as np

D_MODEL = 2048
BATCH = 8
SEQ = 2048
DEPTH = 2

N_MIXERS = 2
N_POOL_LAYERS = (DEPTH + 1) // 2
N_SSM_LAYERS = DEPTH // 2

ALPHA = (2.0 * DEPTH) ** 0.25
BETA = (8.0 * DEPTH) ** -0.25
LN_EPS = 1e-5

POOL_WINDOWS = (2, 4, 8, 16)
N_POOL_GROUPS = len(POOL_WINDOWS)
POOL_GROUP_DIM = D_MODEL // N_POOL_GROUPS

SSM_EXPAND = 2
D_INNER = SSM_EXPAND * D_MODEL
SSM_HEAD_DIM = 64
SSM_HEADS = D_INNER // SSM_HEAD_DIM
SSM_GROUPS = 8
HEADS_PER_GROUP = SSM_HEADS // SSM_GROUPS
D_STATE = 128
CONV_WIDTH = 4
CHUNK = 128
CONV_DIM = D_INNER + 2 * SSM_GROUPS * D_STATE
D_IN_PROJ = D_INNER + CONV_DIM + SSM_HEADS
RMS_EPS = 1e-5

D_FF = 4 * D_MODEL

PLE_DIM = 256

kernel_name = "pool_ssd_interleaved_deepnorm_hybrid"


def layer_norm(x, g, b):
    xf = x.astype(jnp.float32)
    mu = jnp.mean(xf, axis=-1, keepdims=True)
    var = jnp.mean(jnp.square(xf - mu), axis=-1, keepdims=True)
    y = (xf - mu) * lax.rsqrt(var + LN_EPS) * g.astype(jnp.float32) + b.astype(jnp.float32)
    return y.astype(x.dtype)


def rms_norm(x, g):
    xf = x.astype(jnp.float32)
    y = xf * lax.rsqrt(jnp.mean(jnp.square(xf), axis=-1, keepdims=True) + RMS_EPS)
    return y * g.astype(jnp.float32)


def pool_mixer(x, w, scale):
    bsz, seq, _ = x.shape
    xf = x.astype(jnp.float32)
    cs = jnp.cumsum(xf, axis=1)
    pos = jnp.arange(seq)
    outs = []
    for g, win in enumerate(POOL_WINDOWS):
        sl = slice(g * POOL_GROUP_DIM, (g + 1) * POOL_GROUP_DIM)
        c = cs[..., sl]
        c_prev = jnp.pad(c, ((0, 0), (win, 0), (0, 0)))[:, :seq]
        cnt = jnp.minimum(pos + 1, win).astype(jnp.float32)[:, None]
        outs.append((c - c_prev) / cnt - xf[..., sl])
    pooled = jnp.stack(outs, axis=2).astype(x.dtype)
    y = jnp.einsum('bsgc,gcd->bsgd', pooled, w).reshape(bsz, seq, D_MODEL)
    return y * scale


def causal_depthwise_conv(u, w, b):
    seq = u.shape[1]
    up = jnp.pad(u, ((0, 0), (CONV_WIDTH - 1, 0), (0, 0)))
    out = b
    for k in range(CONV_WIDTH):
        out = out + up[:, k:k + seq] * w[k]
    return out


def ssd_mixer(x, in_w, conv_w, conv_b, dt_bias, a_log, d_skip, norm_w, out_w):
    bsz, seq, _ = x.shape
    nc = seq // CHUNK
    zxbcdt = x @ in_w
    z = zxbcdt[..., :D_INNER]
    xbc = zxbcdt[..., D_INNER:D_INNER + CONV_DIM]
    dt = zxbcdt[..., D_INNER + CONV_DIM:]
    xbc = jax.nn.silu(causal_depthwise_conv(xbc, conv_w, conv_b))
    xs = xbc[..., :D_INNER]
    bm = xbc[..., D_INNER:D_INNER + SSM_GROUPS * D_STATE]
    cm = xbc[..., D_INNER + SSM_GROUPS * D_STATE:]

    dt = jax.nn.softplus(dt.astype(jnp.float32) + dt_bias.astype(jnp.float32))
    a = -jnp.exp(a_log.astype(jnp.float32)).reshape(SSM_GROUPS, HEADS_PER_GROUP)

    xs = xs.astype(jnp.float32).reshape(bsz, nc, CHUNK, SSM_GROUPS, HEADS_PER_GROUP, SSM_HEAD_DIM)
    bm = bm.astype(jnp.float32).reshape(bsz, nc, CHUNK, SSM_GROUPS, D_STATE)
    cm = cm.astype(jnp.float32).reshape(bsz, nc, CHUNK, SSM_GROUPS, D_STATE)
    dt = dt.reshape(bsz, nc, CHUNK, SSM_GROUPS, HEADS_PER_GROUP)

    da = jnp.transpose(dt * a, (0, 3, 4, 1, 2))
    a_cs = jnp.cumsum(da, axis=-1)
    xdt = xs * dt[..., None]

    causal = jnp.tril(jnp.ones((CHUNK, CHUNK), dtype=bool))
    seg = a_cs[..., :, None] - a_cs[..., None, :]
    lmat = jnp.exp(jnp.where(causal, seg, -jnp.inf))
    cb = jnp.einsum('bclgn,bcsgn->bgcls', cm, bm)
    mmat = cb[:, :, None] * lmat
    y_diag = jnp.einsum('bghcls,bcsghp->bclghp', mmat, xdt)

    decay_states = jnp.exp(a_cs[..., -1:] - a_cs)
    xdt_dec = xdt * jnp.transpose(decay_states, (0, 3, 4, 1, 2))[..., None]
    states = jnp.einsum('bclgn,bclghp->bcghpn', bm, xdt_dec)
    chunk_decay = jnp.exp(a_cs[..., -1])

    def step(h, inp):
        s, d = inp
        return d[..., None, None] * h + s, h

    h0 = jnp.zeros((bsz, SSM_GROUPS, HEADS_PER_GROUP, SSM_HEAD_DIM, D_STATE), jnp.float32)
    _, prev = lax.scan(step, h0, (jnp.moveaxis(states, 1, 0), jnp.moveaxis(chunk_decay, 3, 0)))
    prev = jnp.moveaxis(prev, 0, 1)

    state_decay = jnp.transpose(jnp.exp(a_cs), (0, 3, 4, 1, 2))
    y_off = jnp.einsum('bclgn,bcghpn->bclghp', cm, prev) * state_decay[..., None]

    dsk = d_skip.astype(jnp.float32).reshape(SSM_GROUPS, HEADS_PER_GROUP)[..., None]
    y = (y_diag + y_off + xs * dsk).reshape(bsz, seq, D_INNER)
    y = rms_norm(y * jax.nn.silu(z.astype(jnp.float32)), norm_w).astype(x.dtype)
    return y @ out_w


def sq_relu_mlp(x, w1, w2):
    h = jax.nn.relu(x @ w1)
    return (h * h) @ w2


def setup_inputs(seed: int = 0) -> dict:
    key = jax.random.key(seed)
    ks = iter(jax.random.split(key, 32))
    f32 = jnp.float32

    def nrm(shape, scale):
        return jax.random.normal(next(ks), shape, f32) * scale

    x = nrm((BATCH, SEQ, D_MODEL), 1.0)
    p = nrm((DEPTH, BATCH, SEQ, PLE_DIM), 1.0)

    pool_w = nrm((N_POOL_LAYERS, N_POOL_GROUPS, POOL_GROUP_DIM, POOL_GROUP_DIM), BETA * POOL_GROUP_DIM ** -0.5)
    pool_scale = 1.0 + nrm((N_POOL_LAYERS, D_MODEL), 0.1)

    ssm_in_w = nrm((N_SSM_LAYERS, D_MODEL, D_IN_PROJ), D_MODEL ** -0.5)
    ssm_conv_w = nrm((N_SSM_LAYERS, CONV_WIDTH, CONV_DIM), CONV_WIDTH ** -0.5)
    ssm_conv_b = nrm((N_SSM_LAYERS, CONV_DIM), 0.02)
    dt0 = jnp.exp(jax.random.uniform(next(ks), (N_SSM_LAYERS, SSM_HEADS), f32,
                                     math.log(1e-3), math.log(1e-1)))
    ssm_dt_bias = dt0 + jnp.log(-jnp.expm1(-dt0))
    ssm_a_log = jnp.log(jax.random.uniform(next(ks), (N_SSM_LAYERS, SSM_HEADS), f32, 1.0, 16.0))
    ssm_d = 1.0 + nrm((N_SSM_LAYERS, SSM_HEADS), 0.1)
    ssm_norm_w = 1.0 + nrm((N_SSM_LAYERS, D_INNER), 0.1)
    ssm_out_w = nrm((N_SSM_LAYERS, D_INNER, D_MODEL), BETA * D_INNER ** -0.5)

    mlp_w1 = nrm((DEPTH, D_MODEL, D_FF), D_MODEL ** -0.5)
    mlp_w2 = nrm((DEPTH, D_FF, D_MODEL), BETA * D_FF ** -0.5)

    ln_g = 1.0 + nrm((DEPTH, 2, D_MODEL), 0.1)
    ln_b = nrm((DEPTH, 2, D_MODEL), 0.02)

    ple_w = nrm((DEPTH, PLE_DIM, D_MODEL), PLE_DIM ** -0.5)
    ple_gate_w = nrm((DEPTH, D_MODEL, D_MODEL), D_MODEL ** -0.5)

    return {"x": x, "p": p,
            "pool_w": pool_w, "pool_scale": pool_scale,
            "ssm_in_w": ssm_in_w, "ssm_conv_w": ssm_conv_w, "ssm_conv_b": ssm_conv_b,
            "ssm_dt_bias": ssm_dt_bias, "ssm_a_log": ssm_a_log, "ssm_d": ssm_d,
            "ssm_norm_w": ssm_norm_w, "ssm_out_w": ssm_out_w,
            "mlp_w1": mlp_w1, "mlp_w2": mlp_w2,
            "ln_g": ln_g, "ln_b": ln_b,
            "ple_w": ple_w, "ple_gate_w": ple_gate_w}


def reference(x, p, pool_w, pool_scale, ssm_in_w, ssm_conv_w, ssm_conv_b,
              ssm_dt_bias, ssm_a_log, ssm_d, ssm_norm_w, ssm_out_w,
              mlp_w1, mlp_w2, ln_g, ln_b, ple_w, ple_gate_w):
    for i in range(DEPTH):
        j = i // N_MIXERS
        if i % N_MIXERS == 0:
            h = pool_mixer(x, pool_w[j], pool_scale[j])
        else:
            h = ssd_mixer(x, ssm_in_w[j], ssm_conv_w[j], ssm_conv_b[j], ssm_dt_bias[j],
                          ssm_a_log[j], ssm_d[j], ssm_norm_w[j], ssm_out_w[j])
        x = layer_norm(ALPHA * x + h, ln_g[i, 0], ln_b[i, 0])
        h = sq_relu_mlp(x, mlp_w1[i], mlp_w2[i])
        x = layer_norm(ALPHA * x + h, ln_g[i, 1], ln_b[i, 1])
        gate = jax.nn.sigmoid(x @ ple_gate_w[i])
        x = x + gate * (p[i] @ ple_w[i])
    return x
```

```cpp
#include <hip/hip_runtime.h>
#include <hip/hip_cooperative_groups.h>
#include <cstdio>
#include <cstdint>
namespace cg = cooperative_groups;

#define LAS __attribute__((address_space(3)))
typedef unsigned short bf16_t;
typedef short bf16x8 __attribute__((ext_vector_type(8)));
typedef float f32x4 __attribute__((ext_vector_type(4)));
typedef float f32x2 __attribute__((ext_vector_type(2)));
typedef unsigned u32x4 __attribute__((ext_vector_type(4)));
typedef unsigned u32x2 __attribute__((ext_vector_type(2)));

constexpr int MROWS = 16384, DM = 2048, DFF = 8192, DIN = 4096, ZXW = 10240, NINP = 10496, NIN = 10304, SEQL = 2048, NB = 8, PLED = 256;
constexpr int NHEAD = 64, HDIM = 64, NGRP = 8, DSTATE = 128, CONVD = 6144, CHUNKL = 128, NCHUNK = 16;
constexpr float ALPHA_F = 1.41421356237309515f;
constexpr float LN_EPS_F = 1e-5f, RMS_EPS_F = 1e-5f;

constexpr size_t MiB = 1024 * 1024;
constexpr size_t WS_SSQ = 0;
constexpr size_t WS_W = 1 * MiB;
constexpr size_t W_W1 = 0, W_W2 = 33554432, W_GATE = 67108864, W_PLE = 75497472, W_A = 76546048, W_OUT = 119537664, W_END = 136314880;
constexpr size_t WS_XB = WS_W + W_END;
constexpr size_t WS_PBF = WS_XB + 67108864;
constexpr size_t WS_DT = WS_PBF + 16777216;
constexpr size_t WS_BIG = WS_DT + 4194304;
constexpr size_t BIG_PW = 268435456;
constexpr size_t WS_END = WS_BIG + 335544320;

constexpr int LDS_BYTES = 163840;

__device__ __forceinline__ unsigned cvt_pk_bf16(float lo, float hi) { unsigned r; asm volatile("v_cvt_pk_bf16_f32 %0, %1, %2" : "=v"(r) : "v"(lo), "v"(hi)); return r; }
__device__ __forceinline__ float bf_lo(unsigned w) { return __uint_as_float(w << 16); }
__device__ __forceinline__ float bf_hi(unsigned w) { return __uint_as_float(w & 0xffff0000u); }
__device__ __forceinline__ float wave_sum(float v) {
#pragma unroll
    for (int o = 1; o < 64; o <<= 1) v += __shfl_xor(v, o);
    return v;
}
__device__ __forceinline__ float fast_sigmoid(float v) { return __builtin_amdgcn_rcpf(1.0f + __expf(-v)); }
__device__ __forceinline__ float fast_silu(float v) { return v * fast_sigmoid(v); }
#define LDS_WAIT() asm volatile("s_waitcnt lgkmcnt(0)" ::: "memory")
__device__ __forceinline__ int launder(int v) { asm volatile("" : "+v"(v)); return v; }

namespace pg8 {
constexpr int BM = 256, BK = 64, HALF = 128, HTB = HALF * BK * 2, STAGE_BYTES = 8 * HTB, NXCD = 8, WGM = 8;
__host__ __device__ __forceinline__ int lds_byte(int r, int c) { const int st = (r >> 4) * 2 + (c >> 5), rr = r & 15, cc = c & 31, ob = rr * 64 + cc * 2; return st * 1024 + (ob ^ (((ob >> 9) & 1) << 5)); }
__host__ __device__ __forceinline__ void stage_rc(int b, int& R, int& C) { const int st = b / 1024, sb = b % 1024, swz = sb ^ (((sb >> 9) & 1) << 5); R = (st >> 1) * 16 + swz / 64; C = (st & 1) * 32 + (swz % 64) / 2; }
__host__ __device__ __forceinline__ int perm32(int rho) { const int n = rho >> 4, i = rho & 15; return 8 * (i >> 2) + 4 * n + (i & 3); }

struct Unit { int pm, pn; };
struct Gemm { const bf16_t* A; const bf16_t* Bt; int lda, ldb, K, tpg, goff; };

struct StaticOrder {
    int nM, nN, nwg, G, c;
    __device__ void init(int M, int N, int G_, int c_) { nM = M / BM; nN = N / BM; nwg = nM * nN; G = G_; c = c_; }
    __device__ bool next(int i, Unit& u) const {
        const long L = (long)i * G + c; if (L >= nwg) return false;
        int wgid = (int)L; { const int q = nwg / NXCD, r = nwg % NXCD, xcd = wgid % NXCD, off = wgid / NXCD; wgid = (xcd < r ? xcd * (q + 1) : r * (q + 1) + (xcd - r) * q) + off; }
        const int nig = WGM * nN, gid = wgid / nig, fm = gid * WGM, gsz = (nM - fm) < WGM ? (nM - fm) : WGM;
        u.pm = fm + ((wgid % nig) % gsz); u.pn = (wgid % nig) / gsz; return true;
    }
};

template <int ACT  > struct EpiBf16 {
    static constexpr bool PERM = true;
    bf16_t* O; int ldc;
    __device__ __forceinline__ void operator()(const f32x4 (&acc)[2][2][4][2], const Unit& u, int wr, int wc, int fr, int fq) const {
        const int row0 = u.pm * BM + wr * 64 + fr, col0 = u.pn * BM + wc * 32 + 8 * fq;
#pragma unroll
        for (int ai = 0; ai < 2; ++ai)
#pragma unroll
            for (int m = 0; m < 4; ++m) { bf16_t* rowp = O + (size_t)(row0 + ai * HALF + m * 16) * ldc + col0;
#pragma unroll
                for (int bj = 0; bj < 2; ++bj) { f32x4 v0 = acc[ai][bj][m][0], v1 = acc[ai][bj][m][1];
                    if (ACT == 1) {
#pragma unroll
                        for (int j = 0; j < 4; ++j) { const float a = fmaxf(v0[j], 0.f), b = fmaxf(v1[j], 0.f); v0[j] = a * a; v1[j] = b * b; }
                        asm volatile("" : "+v"(v0), "+v"(v1)); }
                    u32x4 w; w.x = cvt_pk_bf16(v0[0], v0[1]); w.y = cvt_pk_bf16(v0[2], v0[3]); w.z = cvt_pk_bf16(v1[0], v1[1]); w.w = cvt_pk_bf16(v1[2], v1[3]);
                    *(u32x4*)(rowp + bj * HALF) = w; }
                asm volatile("" ::: "memory"); }
    }
};
struct EpiInProj {
    static constexpr bool PERM = true;
    bf16_t* O; float* DT; const float* dt_bias;
    __device__ __forceinline__ void operator()(const f32x4 (&acc)[2][2][4][2], const Unit& u, int wr, int wc, int fr, int fq) const {
        const int row0 = u.pm * BM + wr * 64 + fr;
        if (u.pn < 40) {
            const int col0 = u.pn * BM + wc * 32 + 8 * fq;
#pragma unroll
            for (int ai = 0; ai < 2; ++ai)
#pragma unroll
                for (int m = 0; m < 4; ++m) { bf16_t* rowp = O + (size_t)(row0 + ai * HALF + m * 16) * ZXW + col0;
#pragma unroll
                    for (int bj = 0; bj < 2; ++bj) { const f32x4 v0 = acc[ai][bj][m][0], v1 = acc[ai][bj][m][1];
                        u32x4 w; w.x = cvt_pk_bf16(v0[0], v0[1]); w.y = cvt_pk_bf16(v0[2], v0[3]); w.z = cvt_pk_bf16(v1[0], v1[1]); w.w = cvt_pk_bf16(v1[2], v1[3]);
                        *(u32x4*)(rowp + bj * HALF) = w; } }
        } else if (wc < 2) {
            const int c0 = wc * 32 + 8 * fq;
            const f32x4 b0 = *(const f32x4*)(dt_bias + c0), b1 = *(const f32x4*)(dt_bias + c0 + 4);
#pragma unroll
            for (int ai = 0; ai < 2; ++ai)
#pragma unroll
                for (int m = 0; m < 4; ++m) { float* rowp = DT + (size_t)(row0 + ai * HALF + m * 16) * 64 + c0;
                    f32x4 v0 = acc[ai][0][m][0] + b0, v1 = acc[ai][0][m][1] + b1;
#pragma unroll
                    for (int j = 0; j < 4; ++j) { v0[j] = v0[j] > 20.f ? v0[j] : log1pf(__expf(v0[j])); v1[j] = v1[j] > 20.f ? v1[j] : log1pf(__expf(v1[j])); }
                    *(f32x4*)rowp = v0; *(f32x4*)(rowp + 4) = v1; }
        }
    }
};
template <int MODE> struct EpiF32 {
    static constexpr bool PERM = false;
    float* XF; const float* xin; const float* scale; const float* ssq; const bf16_t* PW;
    __device__ __forceinline__ void operator()(const f32x4 (&acc)[2][2][4][2], const Unit& u, int wr, int wc, int fr, int fq) const {
        const int row0 = u.pm * BM + wr * 64 + fr, col0 = u.pn * BM + wc * 32 + 4 * fq;
        f32x4 sc[2][2];
        if (MODE == 0) {
#pragma unroll
            for (int bj = 0; bj < 2; ++bj)
#pragma unroll
                for (int n = 0; n < 2; ++n) sc[bj][n] = *(const f32x4*)(scale + col0 + bj * HALF + n * 16);
        }
#pragma unroll
        for (int ai = 0; ai < 2; ++ai)
#pragma unroll
            for (int m = 0; m < 4; ++m) { const int row = row0 + ai * HALF + m * 16; const size_t off = (size_t)row * DM + col0;
                float rs = 1.f; if (MODE == 2) rs = 1.0f / sqrtf(ssq[row] * (1.0f / DIN) + RMS_EPS_F);
#pragma unroll
                for (int bj = 0; bj < 2; ++bj)
#pragma unroll
                    for (int n = 0; n < 2; ++n) { const size_t o = off + bj * HALF + n * 16; const f32x4 a = acc[ai][bj][m][n]; f32x4 r;
                        if (MODE == 0) { const f32x4 xv = *(const f32x4*)(xin + o); r = xv * ALPHA_F + a * sc[bj][n]; }
                        if (MODE == 1) { const f32x4 xv = *(const f32x4*)(XF + o); r = xv * ALPHA_F + a; }
                        if (MODE == 2) { const f32x4 xv = *(const f32x4*)(XF + o); r = xv * ALPHA_F + a * rs; }
                        if (MODE == 3) { const f32x4 xv = *(const f32x4*)(XF + o); const u32x2 pw = *(const u32x2*)(PW + o);
                            r[0] = xv[0] + fast_sigmoid(a[0]) * bf_lo(pw.x); r[1] = xv[1] + fast_sigmoid(a[1]) * bf_hi(pw.x);
                            r[2] = xv[2] + fast_sigmoid(a[2]) * bf_lo(pw.y); r[3] = xv[3] + fast_sigmoid(a[3]) * bf_hi(pw.y); }
                        *(f32x4*)(XF + o) = r; }
                asm volatile("" ::: "memory"); }
    }
};

template <class Epi>
__device__ __forceinline__ void gemm_phase(LAS unsigned char* lds, const Gemm g, const StaticOrder& S, const Epi& E) {
    const int tid = launder((int)threadIdx.x), wid = __builtin_amdgcn_readfirstlane(tid >> 6), lane = tid & 63, wr = wid >> 2, wc = wid & 3, fr = lane & 15, fq = lane >> 4;
    int nt = g.K / BK; asm volatile("" : "+s"(nt));
    unsigned voffA[2], voffB[2];
#pragma unroll
    for (int i = 0; i < 2; ++i) { int R, C; stage_rc(tid * 16 + i * 8192, R, C); const int Rb = Epi::PERM ? ((R & ~31) + perm32(R & 31)) : R;
        voffA[i] = (unsigned)(R * g.lda + C) * 2u; voffB[i] = (unsigned)(Rb * g.ldb + C) * 2u; }
    const size_t kstep = (size_t)(BK * 2);
    const size_t hstepA = (size_t)HALF * g.lda * 2, hstepB = (size_t)HALF * g.ldb * 2;
    const unsigned ldsw = (unsigned)wid * 1024u;
    const int aoff = lds_byte(wr * 64 + fr, fq * 8), boff = lds_byte(wc * 32 + fr, fq * 8);
#define PG8_APTR(u) ((const char*)g.A + (size_t)(u).pm * 2 * hstepA + (size_t)((u).pn / g.tpg) * (size_t)g.goff * 2)
#define PG8_BPTR(u) ((const char*)g.Bt + (size_t)(u).pn * 2 * hstepB)
#define PG8_SA(b, h) (((b) * 2 + (h)) * HTB)
#define PG8_SB(b, h) ((4 + (b) * 2 + (h)) * HTB)
#define PG8_STAGE(bufoff, gbase, voff) do { _Pragma("unroll") for (int _i = 0; _i < 2; ++_i) \
        __builtin_amdgcn_global_load_lds((const unsigned*)((const char*)(gbase) + (voff)[_i]), (LAS unsigned*)(lds + (bufoff) + ldsw + _i * 8192), 16, 0, 0); } while (0)
#define PG8_LDA(dst, b, h) do { _Pragma("unroll") for (int m = 0; m < 4; ++m) _Pragma("unroll") for (int k = 0; k < 2; ++k) dst[m][k] = *(const LAS bf16x8*)(lds + PG8_SA(b, h) + aoff + m * 2048 + k * 1024); } while (0)
#define PG8_LDB(dst, b, h) do { _Pragma("unroll") for (int n = 0; n < 2; ++n) _Pragma("unroll") for (int k = 0; k < 2; ++k) dst[n][k] = *(const LAS bf16x8*)(lds + PG8_SB(b, h) + boff + n * 2048 + k * 1024); } while (0)
#define PG8_MMA(ai, bj, At, Bt) do { __builtin_amdgcn_s_setprio(1); _Pragma("unroll") for (int m = 0; m < 4; ++m) _Pragma("unroll") for (int n = 0; n < 2; ++n) _Pragma("unroll") for (int k = 0; k < 2; ++k) \
        acc[ai][bj][m][n] = __builtin_amdgcn_mfma_f32_16x16x32_bf16(Bt[n][k], At[m][k], acc[ai][bj][m][n], 0, 0, 0); __builtin_amdgcn_s_setprio(0); } while (0)
#define PG8_WAIT_V(n) asm volatile("s_waitcnt vmcnt(" #n ")" ::: "memory")
#define PG8_WAIT_L(n) asm volatile("s_waitcnt lgkmcnt(" #n ")" ::: "memory")
#define PG8_BAR __builtin_amdgcn_s_barrier()
#define PG8_SCHED __builtin_amdgcn_sched_barrier(0)
    Unit cur, nxt; int ui = 0;
    if (!S.next(0, cur)) return;
    f32x4 acc[2][2][4][2];
#pragma unroll
    for (int a = 0; a < 2; ++a)
#pragma unroll
        for (int b = 0; b < 2; ++b)
#pragma unroll
            for (int m = 0; m < 4; ++m)
#pragma unroll
                for (int n = 0; n < 2; ++n) acc[a][b][m][n] = (f32x4){0.f, 0.f, 0.f, 0.f};
    bf16x8 At[4][2], B0[2][2], B1[2][2];
    const char* cA = PG8_APTR(cur); const char* cB = PG8_BPTR(cur);
    PG8_STAGE(PG8_SB(0, 0), cB, voffB); PG8_STAGE(PG8_SB(0, 1), cB + hstepB, voffB); PG8_STAGE(PG8_SA(0, 0), cA, voffA); PG8_STAGE(PG8_SA(0, 1), cA + hstepA, voffA);
    if (wr == 1) PG8_BAR;
    PG8_WAIT_V(2); PG8_BAR;
    PG8_STAGE(PG8_SB(1, 0), cB + kstep, voffB); PG8_STAGE(PG8_SA(1, 0), cA + kstep, voffA); PG8_STAGE(PG8_SB(1, 1), cB + hstepB + kstep, voffB);
    PG8_WAIT_V(6); PG8_BAR;
    for (;;) {
        const bool has_next = S.next(ui + 1, nxt);
        const char* nA = has_next ? PG8_APTR(nxt) : cA; const char* nB = has_next ? PG8_BPTR(nxt) : cB;
        for (int t = 0; t < nt; t += 2) {
            const bool last = (t == nt - 2);
            const char* a1 = cA + (size_t)(t + 1) * kstep;
            const char* a2 = last ? nA : cA + (size_t)(t + 2) * kstep; const char* b2 = last ? nB : cB + (size_t)(t + 2) * kstep;
            const char* a3 = a2 + kstep; const char* b3 = b2 + kstep;
            PG8_LDB(B0, 0, 0); PG8_LDB(B1, 0, 1); PG8_SCHED; PG8_LDA(At, 0, 0); PG8_STAGE(PG8_SA(1, 1), a1 + hstepA, voffA);
            PG8_WAIT_V(8); PG8_WAIT_L(0); PG8_BAR; PG8_MMA(0, 0, At, B0); PG8_MMA(0, 1, At, B1); PG8_BAR; PG8_SCHED;
            PG8_LDA(At, 0, 1); PG8_STAGE(PG8_SB(0, 0), b2, voffB); PG8_STAGE(PG8_SB(0, 1), b2 + hstepB, voffB); PG8_STAGE(PG8_SA(0, 0), a2, voffA);
            PG8_WAIT_V(8); PG8_WAIT_L(0); PG8_BAR; PG8_MMA(1, 0, At, B0); PG8_MMA(1, 1, At, B1); PG8_BAR; PG8_SCHED;
            PG8_LDB(B0, 1, 0); PG8_LDB(B1, 1, 1); PG8_SCHED; PG8_LDA(At, 1, 0); PG8_STAGE(PG8_SA(0, 1), a2 + hstepA, voffA);
            PG8_WAIT_V(8); PG8_WAIT_L(0); PG8_BAR; PG8_MMA(0, 0, At, B0); PG8_MMA(0, 1, At, B1); PG8_BAR; PG8_SCHED;
            PG8_LDA(At, 1, 1); PG8_STAGE(PG8_SB(1, 0), b3, voffB); PG8_STAGE(PG8_SB(1, 1), b3 + hstepB, voffB); PG8_STAGE(PG8_SA(1, 0), a3, voffA);
            PG8_WAIT_V(8); PG8_WAIT_L(0); PG8_BAR; PG8_MMA(1, 0, At, B0); PG8_MMA(1, 1, At, B1); PG8_BAR; PG8_SCHED;
        }
        if (wr == 0) PG8_BAR;
        E(acc, cur, wr, wc, fr, fq);
        if (!has_next) break;
#pragma unroll
        for (int a = 0; a < 2; ++a)
#pragma unroll
            for (int b = 0; b < 2; ++b)
#pragma unroll
                for (int m = 0; m < 4; ++m)
#pragma unroll
                    for (int n = 0; n < 2; ++n) acc[a][b][m][n] = (f32x4){0.f, 0.f, 0.f, 0.f};
        cur = nxt; cA = nA; cB = nB; ++ui;
        if (wr == 1) PG8_BAR;
    }
    PG8_WAIT_V(0);
    PG8_BAR;
#undef PG8_APTR
#undef PG8_BPTR
#undef PG8_SA
#undef PG8_SB
#undef PG8_STAGE
#undef PG8_LDA
#undef PG8_LDB
#undef PG8_MMA
#undef PG8_WAIT_V
#undef PG8_WAIT_L
#undef PG8_BAR
#undef PG8_SCHED
}
}

struct Args {
    const float* x; const float* p; const float* pool_w; const float* pool_scale; const float* ssm_in_w; const float* conv_w; const float* conv_b;
    const float* dt_bias; const float* a_log; const float* d_skip; const float* norm_w; const float* out_w; const float* w1; const float* w2;
    const float* ln_g; const float* ln_b; const float* ple_w; const float* gate_w;
    float* out; unsigned char* ws;
};

typedef __attribute__((address_space(4))) const Args CArgs;
__device__ __forceinline__ CArgs* kargs() { CArgs* p = (CArgs*)__builtin_amdgcn_kernarg_segment_ptr(); asm volatile("" : "+s"(p)); return p; }
#define KA(f) (kargs()->f)

__device__ __forceinline__ void transpose_item(const float* W, int K, int N, bf16_t* WT, int row_off, LAS float* scr, int item, int lane) {
    const int nblk = N / 32, kb = item / nblk, nb = item % nblk, k0 = 64 * kb, n0 = 32 * nb;
#pragma unroll 8
    for (int i = 0; i < 32; ++i) { const int kk = 2 * i + (lane >> 5); scr[kk * 33 + (lane & 31)] = W[(size_t)(k0 + kk) * N + n0 + (lane & 31)]; }
    LDS_WAIT();
    const int c = lane & 7;
#pragma unroll
    for (int j = 0; j < 4; ++j) { const int n = (lane >> 3) + 8 * j; const LAS float* s = scr + (8 * c) * 33 + n;
        u32x4 o; o.x = cvt_pk_bf16(s[0 * 33], s[1 * 33]); o.y = cvt_pk_bf16(s[2 * 33], s[3 * 33]); o.z = cvt_pk_bf16(s[4 * 33], s[5 * 33]); o.w = cvt_pk_bf16(s[6 * 33], s[7 * 33]);
        *(u32x4*)(WT + (size_t)(row_off + n0 + n) * K + k0 + 8 * c) = o; }
    LDS_WAIT();
}
__device__ __forceinline__ void transpose_matrix(const float* W, int K, int N, bf16_t* WT, int row_off, LAS float* scr, int gw, int ngw, int lane) {
    const int nitems = (K / 64) * (N / 32);
    for (int it = gw; it < nitems; it += ngw) transpose_item(W, K, N, WT, row_off, scr, it, lane);
}
__device__ __forceinline__ void cvt_rows(const float* src, bf16_t* dst, size_t n4, size_t gt, size_t ngt) {
    for (size_t i = gt; i < n4; i += ngt) { const f32x4 v = ((const f32x4*)src)[i]; u32x2 w; w.x = cvt_pk_bf16(v[0], v[1]); w.y = cvt_pk_bf16(v[2], v[3]); ((u32x2*)dst)[i] = w; }
}
__device__ __forceinline__ void pool_phase(const float* x, bf16_t* PB, int gt, int ngt) {
    for (int it = gt; it < NB * 128 * 512; it += ngt) {
        const int c4 = it & 511, seg = (it >> 9) & 127, b = it >> 16;
        const int win = 2 << (c4 >> 7);
        const f32x4* xp = (const f32x4*)(x + (size_t)b * SEQL * DM) + c4;
        u32x2* op = (u32x2*)(PB + (size_t)b * SEQL * DM) + c4;
        const int t0 = seg * 16;
        f32x4 s = (f32x4){0.f, 0.f, 0.f, 0.f};
        for (int k = 1; k < win; ++k) { const int t = t0 - k; if (t >= 0) s += xp[(size_t)t * 512]; }
        for (int r = 0; r < 16; ++r) {
            const int t = t0 + r;
            const f32x4 v = xp[(size_t)t * 512];
            s += v;
            const float inv = 1.0f / (float)((t + 1) < win ? (t + 1) : win);
            const f32x4 o = s * inv - v;
            u32x2 w; w.x = cvt_pk_bf16(o[0], o[1]); w.y = cvt_pk_bf16(o[2], o[3]);
            op[(size_t)t * 512] = w;
            const int tp = t - win + 1; if (tp >= 0) s -= xp[(size_t)tp * 512];
        }
    }
}
__device__ __forceinline__ void ln_phase(float* XF, bf16_t* XB, const float* g, const float* bta, int gw, int ngw, int lane) {
    f32x4 gv[8], bv[8];
#pragma unroll
    for (int j = 0; j < 8; ++j) { gv[j] = ((const f32x4*)g)[lane + 64 * j]; bv[j] = ((const f32x4*)bta)[lane + 64 * j]; }
    for (int row = gw; row < MROWS; row += ngw) {
        f32x4* xr = (f32x4*)(XF + (size_t)row * DM) + lane;
        f32x4 v[8]; float s = 0.f;
#pragma unroll
        for (int j = 0; j < 8; ++j) { v[j] = xr[64 * j]; s += (v[j][0] + v[j][1]) + (v[j][2] + v[j][3]); }
        const float mean = wave_sum(s) * (1.0f / DM); float s2 = 0.f;
#pragma unroll
        for (int j = 0; j < 8; ++j) { v[j] = v[j] - mean; s2 += (v[j][0] * v[j][0] + v[j][1] * v[j][1]) + (v[j][2] * v[j][2] + v[j][3] * v[j][3]); }
        const float rstd = 1.0f / sqrtf(wave_sum(s2) * (1.0f / DM) + LN_EPS_F);
        u32x2* ob = (u32x2*)(XB + (size_t)row * DM) + lane;
#pragma unroll
        for (int j = 0; j < 8; ++j) { const f32x4 y = v[j] * rstd * gv[j] + bv[j]; xr[64 * j] = y;
            u32x2 w; w.x = cvt_pk_bf16(y[0], y[1]); w.y = cvt_pk_bf16(y[2], y[3]); ob[64 * j] = w; }
    }
}

constexpr int SST = 272;
constexpr int L_SC = 0, L_SB = 34816, L_SM = 69632, L_SXT = 104448, L_SST = 121856, L_SX = 139264, SXS = 144, L_ACS = 157696, L_SSD_END = 158208;
static_assert(L_SSD_END <= LDS_BYTES, "SSD LDS map");

#define UNPK(dst, SRC_) do { dst[0] = bf_lo((SRC_).x); dst[1] = bf_hi((SRC_).x); dst[2] = bf_lo((SRC_).y); dst[3] = bf_hi((SRC_).y); dst[4] = bf_lo((SRC_).z); dst[5] = bf_hi((SRC_).z); dst[6] = bf_lo((SRC_).w); dst[7] = bf_hi((SRC_).w); } while (0)
__device__ __forceinline__ void ssd_phase(LAS unsigned char* lds, bf16_t* zx, const float* DTp, const float* conv_w, const float* conv_b, const float* a_log,
                                          const float* d_skip, const float* norm_w, float* ssq) {
    const int tid = launder((int)threadIdx.x), wid = __builtin_amdgcn_readfirstlane(tid >> 6), lane = tid & 63, fr = lane & 15, fq = lane >> 4;
    const int bx = blockIdx.x, xcd = bx & 7, slot = bx >> 3;
    LAS float* sAcs = (LAS float*)(lds + L_ACS);
    for (int round = 0; round < 2; ++round) {
        int b, h;
        if (gridDim.x == 256) { const int q = ((slot >> 3) + 4 * round) * 8 + xcd; b = q >> 3; h = (q & 7) * 8 + (slot & 7); }
        else { const int item = bx + round * (int)gridDim.x; if (item >= NB * NHEAD) break; b = item >> 6; h = item & 63; }
        const int g = h >> 3;
        const float a_h = -__expf(a_log[h]), d_h = d_skip[h];
        const int cg = tid % 40, rseg = tid / 40;
        const bool conv_thr = tid < 320;
        int ch = 0;
        if (cg < 8) ch = h * 64 + cg * 8; else if (cg < 24) ch = DIN + g * 128 + (cg - 8) * 8; else ch = DIN + NGRP * DSTATE + g * 128 + (cg - 24) * 8;
        float cw[4][8], cb[8];
        if (conv_thr) {
#pragma unroll
            for (int k = 0; k < 4; ++k) { const f32x4 w0 = *(const f32x4*)(conv_w + k * CONVD + ch), w1 = *(const f32x4*)(conv_w + k * CONVD + ch + 4);
#pragma unroll
                for (int i = 0; i < 4; ++i) { cw[k][i] = w0[i]; cw[k][4 + i] = w1[i]; } }
            const f32x4 b0 = *(const f32x4*)(conv_b + ch), b1 = *(const f32x4*)(conv_b + ch + 4);
#pragma unroll
            for (int i = 0; i < 4; ++i) { cb[i] = b0[i]; cb[4 + i] = b1[i]; }
        }
        f32x4 st[4];
#pragma unroll
        for (int i = 0; i < 4; ++i) st[i] = (f32x4){0.f, 0.f, 0.f, 0.f};
        __syncthreads();
        for (int i = tid; i < 64 * SST / 4; i += 512) ((LAS unsigned*)(lds + L_SST))[i] = 0u;
        for (int c = 0; c < NCHUNK; ++c) {
            __syncthreads();
            if (conv_thr) {
                const int tseg = c * CHUNKL + rseg * 16;
                const bf16_t* src = zx + ((size_t)b * SEQL) * ZXW + DIN + ch;
                float u0[8], u1[8], u2[8];
                {
                    u32x4 hal[3];
#pragma unroll
                    for (int r = 0; r < 3; ++r) { const int t = tseg + r - 3; hal[r] = (t >= 0) ? *(const u32x4*)(src + (size_t)t * ZXW) : (u32x4){0u, 0u, 0u, 0u}; }
                    UNPK(u0, hal[0]); UNPK(u1, hal[1]); UNPK(u2, hal[2]);
                }
#pragma unroll 1
                for (int hf = 0; hf < 2; ++hf) {
                    u32x4 raw[8];
#pragma unroll
                    for (int r = 0; r < 8; ++r) raw[r] = *(const u32x4*)(src + (size_t)(tseg + hf * 8 + r) * ZXW);
                    float dtv[8];
                    if (cg < 8) {
#pragma unroll
                        for (int r = 0; r < 8; ++r) dtv[r] = DTp[((size_t)b * SEQL + tseg + hf * 8 + r) * 64 + h];
                    }
#pragma unroll
                    for (int r = 0; r < 8; ++r) {
                        float cu[8], v[8]; UNPK(cu, raw[r]);
#pragma unroll
                        for (int i = 0; i < 8; ++i) { const float a = cb[i] + cw[0][i] * u0[i] + cw[1][i] * u1[i] + cw[2][i] * u2[i] + cw[3][i] * cu[i]; v[i] = fast_silu(a); u0[i] = u1[i]; u1[i] = u2[i]; u2[i] = cu[i]; }
                        const int l = rseg * 16 + hf * 8 + r;
                        u32x4 w; w.x = cvt_pk_bf16(v[0], v[1]); w.y = cvt_pk_bf16(v[2], v[3]); w.z = cvt_pk_bf16(v[4], v[5]); w.w = cvt_pk_bf16(v[6], v[7]);
                        if (cg >= 24) *(LAS u32x4*)(lds + L_SC + l * SST + (cg - 24) * 16) = w;
                        else if (cg >= 8) *(LAS u32x4*)(lds + L_SB + l * SST + (cg - 8) * 16) = w;
                        else {
                            *(LAS u32x4*)(lds + L_SX + l * SXS + cg * 16) = w;
                            const float d = dtv[r];
#pragma unroll
                            for (int i = 0; i < 8; i += 2) { const unsigned pk = cvt_pk_bf16(v[i] * d, v[i + 1] * d);
                                *(LAS unsigned short*)(lds + L_SXT + (cg * 8 + i) * SST + l * 2) = (unsigned short)(pk & 0xffffu);
                                *(LAS unsigned short*)(lds + L_SXT + (cg * 8 + i + 1) * SST + l * 2) = (unsigned short)(pk >> 16); }
                        }
                    }
                }
            } else if (wid == 7) {
                const size_t r0 = (size_t)b * SEQL + c * CHUNKL + 2 * lane;
                const float da0 = DTp[r0 * 64 + h] * a_h, da1 = DTp[(r0 + 1) * 64 + h] * a_h;
                float s = da0 + da1;
#pragma unroll
                for (int o = 1; o < 64; o <<= 1) { const float t = __shfl_up(s, o); if (lane >= o) s += t; }
                sAcs[2 * lane] = s - da1; sAcs[2 * lane + 1] = s;
            }
            __syncthreads();
            const int l0 = wid * 16, kbmax = wid >> 1;
            {
                bf16x8 yc[4];
#pragma unroll
                for (int kb = 0; kb < 4; ++kb) yc[kb] = *(const LAS bf16x8*)(lds + L_SC + (l0 + fr) * SST + kb * 64 + fq * 16);
                const float acs_l = sAcs[l0 + fr];
                for (int stl = 0; stl <= 2 * kbmax + 1; ++stl) {
                    f32x4 a = (f32x4){0.f, 0.f, 0.f, 0.f};
                    if (stl <= wid) {
#pragma unroll
                        for (int kb = 0; kb < 4; ++kb) { const bf16x8 xb = *(const LAS bf16x8*)(lds + L_SB + (stl * 16 + fr) * SST + kb * 64 + fq * 16);
                            a = __builtin_amdgcn_mfma_f32_16x16x32_bf16(xb, yc[kb], a, 0, 0, 0); }
                        const f32x4 as = *(const LAS f32x4*)(lds + L_ACS + (stl * 16 + 4 * fq) * 4);
#pragma unroll
                        for (int r = 0; r < 4; ++r) { const int s = stl * 16 + 4 * fq + r; a[r] = (s <= l0 + fr) ? a[r] * __expf(acs_l - as[r]) : 0.f; }
                    }
                    u32x2 w; w.x = cvt_pk_bf16(a[0], a[1]); w.y = cvt_pk_bf16(a[2], a[3]);
                    *(LAS u32x2*)(lds + L_SM + (l0 + fr) * SST + (stl * 16 + 4 * fq) * 2) = w;
                }
            }
            __syncthreads();
            {
                f32x4 yd[4], yo[4];
#pragma unroll
                for (int i = 0; i < 4; ++i) { yd[i] = (f32x4){0.f, 0.f, 0.f, 0.f}; yo[i] = (f32x4){0.f, 0.f, 0.f, 0.f}; }
                for (int kb = 0; kb <= kbmax; ++kb) { const bf16x8 ym = *(const LAS bf16x8*)(lds + L_SM + (l0 + fr) * SST + kb * 64 + fq * 16);
#pragma unroll
                    for (int pt = 0; pt < 4; ++pt) { const bf16x8 xx = *(const LAS bf16x8*)(lds + L_SXT + (pt * 16 + fr) * SST + kb * 64 + fq * 16);
                        yd[pt] = __builtin_amdgcn_mfma_f32_16x16x32_bf16(xx, ym, yd[pt], 0, 0, 0); } }
#pragma unroll
                for (int kb = 0; kb < 4; ++kb) { const bf16x8 yc = *(const LAS bf16x8*)(lds + L_SC + (l0 + fr) * SST + kb * 64 + fq * 16);
#pragma unroll
                    for (int pt = 0; pt < 4; ++pt) { const bf16x8 xs = *(const LAS bf16x8*)(lds + L_SST + (pt * 16 + fr) * SST + kb * 64 + fq * 16);
                        yo[pt] = __builtin_amdgcn_mfma_f32_16x16x32_bf16(xs, yc, yo[pt], 0, 0, 0); } }
                const int l = l0 + fr; const float el = __expf(sAcs[l]);
                const size_t row = (size_t)b * SEQL + c * CHUNKL + l;
                bf16_t* zp = zx + row * ZXW + h * 64 + 4 * fq;
                const float* nwp = norm_w + h * 64 + 4 * fq;
                float sq = 0.f;
#pragma unroll
                for (int pt = 0; pt < 4; ++pt) {
                    const u32x2 xw = *(const LAS u32x2*)(lds + L_SX + l * SXS + (pt * 16 + 4 * fq) * 2);
                    const u32x2 zw = *(const u32x2*)(zp + pt * 16);
                    const f32x4 nw = *(const f32x4*)(nwp + pt * 16);
                    float y0 = yd[pt][0] + el * yo[pt][0] + d_h * bf_lo(xw.x), y1 = yd[pt][1] + el * yo[pt][1] + d_h * bf_hi(xw.x);
                    float y2 = yd[pt][2] + el * yo[pt][2] + d_h * bf_lo(xw.y), y3 = yd[pt][3] + el * yo[pt][3] + d_h * bf_hi(xw.y);
                    y0 *= fast_silu(bf_lo(zw.x)); y1 *= fast_silu(bf_hi(zw.x)); y2 *= fast_silu(bf_lo(zw.y)); y3 *= fast_silu(bf_hi(zw.y));
                    sq += (y0 * y0 + y1 * y1) + (y2 * y2 + y3 * y3);
                    u32x2 w; w.x = cvt_pk_bf16(y0 * nw[0], y1 * nw[1]); w.y = cvt_pk_bf16(y2 * nw[2], y3 * nw[3]);
                    *(u32x2*)(zp + pt * 16) = w;
                }
                sq += __shfl_xor(sq, 16); sq += __shfl_xor(sq, 32);
                if (fq == 0) atomicAdd(ssq + row, sq);
            }
            __syncthreads();
            const float acs_end = sAcs[CHUNKL - 1];
#pragma unroll
            for (int i = 0; i < 4; ++i) { const int item = tid + 512 * i, l = item & 127, ng = item >> 7;
                const float dec = __expf(acs_end - sAcs[l]);
                const u32x4 w = *(const LAS u32x4*)(lds + L_SB + l * SST + ng * 16);
                float v[8]; UNPK(v, w);
#pragma unroll
                for (int j = 0; j < 8; j += 2) { const unsigned pk = cvt_pk_bf16(v[j] * dec, v[j + 1] * dec);
                    *(LAS unsigned short*)(lds + L_SM + (ng * 8 + j) * SST + l * 2) = (unsigned short)(pk & 0xffffu);
                    *(LAS unsigned short*)(lds + L_SM + (ng * 8 + j + 1) * SST + l * 2) = (unsigned short)(pk >> 16); } }
            __syncthreads();
            {
                const float ce = __expf(acs_end);
#pragma unroll
                for (int pt = 0; pt < 4; ++pt) st[pt] = st[pt] * ce;
#pragma unroll
                for (int kb = 0; kb < 4; ++kb) { const bf16x8 xb = *(const LAS bf16x8*)(lds + L_SM + (l0 + fr) * SST + kb * 64 + fq * 16);
#pragma unroll
                    for (int pt = 0; pt < 4; ++pt) { const bf16x8 yx = *(const LAS bf16x8*)(lds + L_SXT + (pt * 16 + fr) * SST + kb * 64 + fq * 16);
                        st[pt] = __builtin_amdgcn_mfma_f32_16x16x32_bf16(xb, yx, st[pt], 0, 0, 0); } }
#pragma unroll
                for (int pt = 0; pt < 4; ++pt) { u32x2 w; w.x = cvt_pk_bf16(st[pt][0], st[pt][1]); w.y = cvt_pk_bf16(st[pt][2], st[pt][3]);
                    *(LAS u32x2*)(lds + L_SST + (pt * 16 + fr) * SST + (l0 + 4 * fq) * 2) = w; }
            }
        }
#undef UNPK
    }
    __syncthreads();
}

#ifdef NO_GEMM
#define GEMM_CALL(l, g, S, E) do { (void)g; (void)S; (void)E; } while (0)
#else
#define GEMM_CALL(l, g, S, E) pg8::gemm_phase(l, g, S, E)
#endif
#if defined(ONLY_GEMM) && ONLY_GEMM != 1
#define GEMM_CALL1(l, g, S, E) do { (void)g; (void)S; (void)E; } while (0)
#else
#define GEMM_CALL1(l, g, S, E) GEMM_CALL(l, g, S, E)
#endif
#if defined(ONLY_GEMM) && ONLY_GEMM != 2
#define GEMM_CALL2(l, g, S, E) do { (void)g; (void)S; (void)E; } while (0)
#else
#define GEMM_CALL2(l, g, S, E) GEMM_CALL(l, g, S, E)
#endif
#if defined(ONLY_GEMM) && ONLY_GEMM != 3
#define GEMM_CALL3(l, g, S, E) do { (void)g; (void)S; (void)E; } while (0)
#else
#define GEMM_CALL3(l, g, S, E) GEMM_CALL(l, g, S, E)
#endif
#if defined(ONLY_GEMM) && ONLY_GEMM != 4
#define GEMM_CALL4(l, g, S, E) do { (void)g; (void)S; (void)E; } while (0)
#else
#define GEMM_CALL4(l, g, S, E) GEMM_CALL(l, g, S, E)
#endif
#if defined(ONLY_GEMM) && ONLY_GEMM != 5
#define GEMM_CALL5(l, g, S, E) do { (void)g; (void)S; (void)E; } while (0)
#else
#define GEMM_CALL5(l, g, S, E) GEMM_CALL(l, g, S, E)
#endif
#if defined(ONLY_GEMM) && ONLY_GEMM != 6
#define GEMM_CALL6(l, g, S, E) do { (void)g; (void)S; (void)E; } while (0)
#else
#define GEMM_CALL6(l, g, S, E) GEMM_CALL(l, g, S, E)
#endif
#if defined(ONLY_GEMM) && ONLY_GEMM != 7
#define GEMM_CALL7(l, g, S, E) do { (void)g; (void)S; (void)E; } while (0)
#else
#define GEMM_CALL7(l, g, S, E) GEMM_CALL(l, g, S, E)
#endif
__global__ void __launch_bounds__(512, 2) fwd_megakernel(Args a) {
    extern __shared__ __attribute__((aligned(16))) unsigned char lds_raw[];
    LAS unsigned char* lds = (LAS unsigned char*)lds_raw;
    cg::grid_group grid = cg::this_grid();
    const int G = gridDim.x, ngw = G * 8, ngt = G * 512;
#define SSQ ((float*)(KA(ws) + WS_SSQ))
#define W1t ((bf16_t*)(KA(ws) + WS_W + W_W1))
#define W2t ((bf16_t*)(KA(ws) + WS_W + W_W2))
#define WGt ((bf16_t*)(KA(ws) + WS_W + W_GATE))
#define WPt ((bf16_t*)(KA(ws) + WS_W + W_PLE))
#define WAt ((bf16_t*)(KA(ws) + WS_W + W_A))
#define WOt ((bf16_t*)(KA(ws) + WS_W + W_OUT))
#define XB ((bf16_t*)(KA(ws) + WS_XB))
#define PBF ((bf16_t*)(KA(ws) + WS_PBF))
#define DT ((float*)(KA(ws) + WS_DT))
#define BIG ((bf16_t*)(KA(ws) + WS_BIG))
#define PW ((bf16_t*)(KA(ws) + WS_BIG + BIG_PW))
#define XF (KA(out))

    for (int layer = 0; layer < 2; ++layer) {
        const int tid = launder((int)threadIdx.x), lane = tid & 63, wave = __builtin_amdgcn_readfirstlane(tid >> 6);
        const int gw = blockIdx.x * 8 + wave, gt = blockIdx.x * 512 + tid;
        LAS float* scr = (LAS float*)(lds + wave * 16384);
#ifndef NO_THIN
        transpose_matrix(KA(w1) + (size_t)layer * DM * DFF, DM, DFF, W1t, 0, scr, gw, ngw, lane);
        transpose_matrix(KA(w2) + (size_t)layer * DFF * DM, DFF, DM, W2t, 0, scr, gw, ngw, lane);
        transpose_matrix(KA(gate_w) + (size_t)layer * DM * DM, DM, DM, WGt, 0, scr, gw, ngw, lane);
        transpose_matrix(KA(ple_w) + (size_t)layer * PLED * DM, PLED, DM, WPt, 0, scr, gw, ngw, lane);
        if (layer == 0) {
            for (int gi = 0; gi < 4; ++gi) transpose_matrix(KA(pool_w) + (size_t)gi * 512 * 512, 512, 512, WAt, gi * 512, scr, gw, ngw, lane);
            pool_phase(KA(x), BIG, gt, ngt);
            cvt_rows(KA(p), PBF, (size_t)2 * MROWS * PLED / 4, gt, ngt);
        } else {
            transpose_matrix(KA(ssm_in_w), DM, NIN, WAt, 0, scr, gw, ngw, lane);
            transpose_matrix(KA(out_w), DIN, DM, WOt, 0, scr, gw, ngw, lane);
            cvt_rows(XF, XB, (size_t)MROWS * DM / 4, gt, ngt);
            for (int i = gt; i < MROWS; i += ngt) SSQ[i] = 0.f;
        }
#endif
        grid.sync();
        if (layer == 0) {
            pg8::Gemm g{BIG, WAt, DM, 512, 512, 2, 512}; pg8::StaticOrder S; S.init(MROWS, DM, G, (int)blockIdx.x);
            pg8::EpiF32<0> E{XF, KA(x), KA(pool_scale), nullptr, nullptr};
            GEMM_CALL1(lds, g, S, E);
            grid.sync();
        } else {
            { pg8::Gemm g{XB, WAt, DM, DM, DM, 1 << 20, 0}; pg8::StaticOrder S; S.init(MROWS, NINP, G, (int)blockIdx.x);
              pg8::EpiInProj E{BIG, DT, KA(dt_bias)};
              GEMM_CALL2(lds, g, S, E); }
            grid.sync();
#ifndef NO_SSD
            ssd_phase(lds, BIG, DT, KA(conv_w), KA(conv_b), KA(a_log), KA(d_skip), KA(norm_w), SSQ);
#endif
            grid.sync();
            { pg8::Gemm g{BIG, WOt, ZXW, DIN, DIN, 1 << 20, 0}; pg8::StaticOrder S; S.init(MROWS, DM, G, (int)blockIdx.x);
              pg8::EpiF32<2> E{XF, nullptr, nullptr, SSQ, nullptr};
              GEMM_CALL3(lds, g, S, E); }
            grid.sync();
        }
#ifndef NO_THIN
        ln_phase(XF, XB, KA(ln_g) + (size_t)(layer * 2 + 0) * DM, KA(ln_b) + (size_t)(layer * 2 + 0) * DM, gw, ngw, lane);
#endif
        grid.sync();
        { pg8::Gemm g{PBF + (size_t)layer * MROWS * PLED, WPt, PLED, PLED, PLED, 1 << 20, 0}; pg8::StaticOrder S; S.init(MROWS, DM, G, (int)blockIdx.x);
          pg8::EpiBf16<0> E{PW, DM};
          GEMM_CALL4(lds, g, S, E); }
        { pg8::Gemm g{XB, W1t, DM, DM, DM, 1 << 20, 0}; pg8::StaticOrder S; S.init(MROWS, DFF, G, (int)blockIdx.x);
          pg8::EpiBf16<1> E{BIG, DFF};
          GEMM_CALL5(lds, g, S, E); }
        grid.sync();
        { pg8::Gemm g{BIG, W2t, DFF, DFF, DFF, 1 << 20, 0}; pg8::StaticOrder S; S.init(MROWS, DM, G, (int)blockIdx.x);
          pg8::EpiF32<1> E{XF, nullptr, nullptr, nullptr, nullptr};
          GEMM_CALL6(lds, g, S, E); }
        grid.sync();
#ifndef NO_THIN
        ln_phase(XF, XB, KA(ln_g) + (size_t)(layer * 2 + 1) * DM, KA(ln_b) + (size_t)(layer * 2 + 1) * DM, gw, ngw, lane);
#endif
        grid.sync();
        { pg8::Gemm g{XB, WGt, DM, DM, DM, 1 << 20, 0}; pg8::StaticOrder S; S.init(MROWS, DM, G, (int)blockIdx.x);
          pg8::EpiF32<3> E{XF, nullptr, nullptr, nullptr, PW};
          GEMM_CALL7(lds, g, S, E); }
        if (layer == 0) grid.sync();
    }
}

extern "C" void kernel_launch(void* const* d_in, const int* in_sizes, int n_in, void* d_out, int out_size, void* d_ws, size_t ws_size, hipStream_t stream) {
    static int grid = 0;
    if (grid == 0) {
        if (n_in != 18 || in_sizes[0] != MROWS * DM || out_size != MROWS * DM || ws_size < WS_END) {
            fprintf(stderr, "kernel_launch: unexpected shapes (n_in %d, in0 %d, out %d, ws %zu, need %zu); nothing launched\n", n_in, n_in > 0 ? in_sizes[0] : -1, out_size, ws_size, (size_t)WS_END);
            grid = -1; return; }
        int dev = 0, cus = 0, per_cu = 0;
        if (hipGetDevice(&dev) != hipSuccess || hipDeviceGetAttribute(&cus, hipDeviceAttributeMultiprocessorCount, dev) != hipSuccess) { grid = -1; return; }
        if (hipFuncSetAttribute((const void*)fwd_megakernel, hipFuncAttributeMaxDynamicSharedMemorySize, LDS_BYTES) != hipSuccess) { fprintf(stderr, "kernel_launch: hipFuncSetAttribute failed\n"); grid = -1; return; }
        if (hipOccupancyMaxActiveBlocksPerMultiprocessor(&per_cu, (const void*)fwd_megakernel, 512, LDS_BYTES) != hipSuccess || per_cu < 1) { fprintf(stderr, "kernel_launch: occupancy query says %d blocks per CU\n", per_cu); per_cu = 1; }
        (void)hipGetLastError();
        grid = cus;
    }
    if (grid < 0) return;
    Args a{};
    a.x = (const float*)d_in[0]; a.p = (const float*)d_in[1]; a.pool_w = (const float*)d_in[2]; a.pool_scale = (const float*)d_in[3]; a.ssm_in_w = (const float*)d_in[4];
    a.conv_w = (const float*)d_in[5]; a.conv_b = (const float*)d_in[6]; a.dt_bias = (const float*)d_in[7]; a.a_log = (const float*)d_in[8]; a.d_skip = (const float*)d_in[9];
    a.norm_w = (const float*)d_in[10]; a.out_w = (const float*)d_in[11]; a.w1 = (const float*)d_in[12]; a.w2 = (const float*)d_in[13]; a.ln_g = (const float*)d_in[14];
    a.ln_b = (const float*)d_in[15]; a.ple_w = (const float*)d_in[16]; a.gate_w = (const float*)d_in[17];
    a.out = (float*)d_out; a.ws = (unsigned char*)d_ws;
    void* args[] = {&a};
    const hipError_t e = hipLaunchCooperativeKernel((const void*)fwd_megakernel, dim3(grid), dim3(512), args, LDS_BYTES, stream);
    if (e != hipSuccess) fprintf(stderr, "kernel_launch: cooperative launch failed: %s (grid %d)\n", hipGetErrorString(e), grid);
}
```

```cpp
#include <hip/hip_runtime.h>
#include <hip/hip_cooperative_groups.h>
#include <cstdio>
#include <cstdint>
namespace cg = cooperative_groups;

#define LAS __attribute__((address_space(3)))
typedef unsigned short bf16_t;
typedef short bf16x8 __attribute__((ext_vector_type(8)));
typedef float f32x4 __attribute__((ext_vector_type(4)));
typedef float f32x2 __attribute__((ext_vector_type(2)));
typedef unsigned u32x4 __attribute__((ext_vector_type(4)));
typedef unsigned u32x2 __attribute__((ext_vector_type(2)));

constexpr int MROWS = 16384, DM = 2048, DFF = 8192, DIN = 4096, ZXW = 10240, NINP = 10496, NIN = 10304, SEQL = 2048, NB = 8, PLED = 256;
constexpr int NHEAD = 64, HDIM = 64, NGRP = 8, DSTATE = 128, CONVD = 6144, CHUNKL = 128, NCHUNK = 16;
constexpr float ALPHA_F = 1.41421356237309515f;
constexpr float LN_EPS_F = 1e-5f, RMS_EPS_F = 1e-5f;

constexpr size_t MiB = 1024 * 1024;
constexpr size_t WS_SSQ = 0;
constexpr size_t WS_BAR = 131072;
constexpr size_t WS_W = 1 * MiB;
constexpr size_t W_W1 = 0, W_W2 = 33554432, W_GATE = 67108864, W_PLE = 75497472, W_A = 76546048, W_OUT = 119537664, W_END = 136314880;
constexpr size_t WS_XB = WS_W + W_END;
constexpr size_t WS_PBF = WS_XB + 67108864;
constexpr size_t WS_DT = WS_PBF + 16777216;
constexpr size_t WS_BIG = WS_DT + 4194304;
constexpr size_t BIG_PW = 268435456;
constexpr size_t WS_END = WS_BIG + 335544320;

constexpr int LDS_BYTES = 163840, L_BARST = 163824;

__device__ __forceinline__ unsigned cvt_pk_bf16(float lo, float hi) { unsigned r; asm volatile("v_cvt_pk_bf16_f32 %0, %1, %2" : "=v"(r) : "v"(lo), "v"(hi)); return r; }
__device__ __forceinline__ float bf_lo(unsigned w) { return __uint_as_float(w << 16); }
__device__ __forceinline__ float bf_hi(unsigned w) { return __uint_as_float(w & 0xffff0000u); }
__device__ __forceinline__ float wave_sum(float v) {
#pragma unroll
    for (int o = 1; o < 64; o <<= 1) v += __shfl_xor(v, o);
    return v;
}
__device__ __forceinline__ float fast_sigmoid(float v) { return __builtin_amdgcn_rcpf(1.0f + __expf(-v)); }
__device__ __forceinline__ float fast_silu(float v) { return v * fast_sigmoid(v); }
#define LDS_WAIT() asm volatile("s_waitcnt lgkmcnt(0)" ::: "memory")
__device__ __forceinline__ int launder(int v) { asm volatile("" : "+v"(v)); return v; }


#define XB_TMO      128
#define XB_XCNT(j)  (256  + 64 * (j))
#define XB_XSUB(j)  (1280 + 64 * (j))
#define XB_XGEN(j)  (2304 + 64 * (j))
#define XB_TOP      3328
#define XB_TOPGEN   3392
#define XCD_BAR_WORDS 3456
#define XB_SPIN_CAP (1u << 20)
__device__ __forceinline__ unsigned xb_ld(unsigned* p)              { return __hip_atomic_load(p, __ATOMIC_RELAXED, __HIP_MEMORY_SCOPE_AGENT); }
__device__ __forceinline__ unsigned xb_add(unsigned* p, unsigned v) { return __hip_atomic_fetch_add(p, v, __ATOMIC_RELAXED, __HIP_MEMORY_SCOPE_AGENT); }
__device__ __forceinline__ unsigned xb_xcc_id() { return (unsigned)__builtin_amdgcn_s_getreg((3 << 11) | 20) & 0xFu; }
#define XB_SPIN(cond, bar) do { unsigned _sp = 0; while (cond) { __builtin_amdgcn_s_sleep(1); \
    if ((++_sp & 255u) == 0u) { if (xb_ld(&(bar)[XB_TMO])) break; if (_sp > XB_SPIN_CAP) { atomicAdd(&(bar)[XB_TMO], 1u); break; } } } } while (0)
__device__ __forceinline__ void xcd_barrier_post(unsigned* bar) { if (threadIdx.x == 0) (void)xb_add(&bar[XB_XCNT(xb_xcc_id())], 1u); }
__device__ __forceinline__ void xcd_barrier_complete(unsigned* bar, unsigned x, unsigned& nloc, unsigned& nx) {
    const unsigned G = gridDim.x;
    unsigned sum, cnt, mine, sp = 0u;
    for (;;) {
        sum = 0u; cnt = 0u; mine = 0u;
#pragma unroll
        for (unsigned j = 0; j < 16; ++j) { const unsigned c = xb_ld(&bar[XB_XCNT(j)]); sum += c; cnt += (c > 0u) ? 1u : 0u; mine = (j == x) ? c : mine; }
        if (sum == G) break;
        __builtin_amdgcn_s_sleep(1);
        if ((++sp & 255u) == 0u) { if (xb_ld(&bar[XB_TMO])) break; if (sp > XB_SPIN_CAP) { atomicAdd(&bar[XB_TMO], 1u); break; } }
    }
    nloc = mine > 0u ? mine : 1u; nx = cnt > 0u ? cnt : 1u;
}
__device__ __forceinline__ void xcd_barrier(unsigned* bar, volatile LAS unsigned* st) {
    asm volatile("s_waitcnt vmcnt(0)" ::: "memory");
    __syncthreads();
    if (threadIdx.x == 0) {
        __builtin_amdgcn_s_waitcnt(0);
        const unsigned x = xb_xcc_id();
        unsigned nloc = st[0], nx = st[1];
        if (nloc == 0u) { xcd_barrier_complete(bar, x, nloc, nx); st[0] = nloc; st[1] = nx; }
        const unsigned old = xb_add(&bar[XB_XSUB(x)], 1u);
        const unsigned gen = old / nloc;
        if (old + 1u == (gen + 1u) * nloc) {
            __builtin_amdgcn_fence(__ATOMIC_RELEASE, "agent");
            asm volatile("s_waitcnt vmcnt(0)" ::: "memory");
            const unsigned og = xb_add(&bar[XB_TOP], 1u);
            const unsigned tg = og / nx;
            if (og + 1u == (tg + 1u) * nx) xb_add(&bar[XB_TOPGEN], 1u);
            else XB_SPIN(xb_ld(&bar[XB_TOPGEN]) == tg, bar);
            __builtin_amdgcn_fence(__ATOMIC_ACQUIRE, "agent");
            xb_add(&bar[XB_XGEN(x)], 1u);
            asm volatile("s_waitcnt vmcnt(0)" ::: "memory");
        } else {
            XB_SPIN(xb_ld(&bar[XB_XGEN(x)]) == gen, bar);
            __builtin_amdgcn_fence(__ATOMIC_ACQUIRE, "agent");
            asm volatile("s_waitcnt vmcnt(0)" ::: "memory");
        }
    }
    __syncthreads();
}

namespace pg8 {
constexpr int BM = 256, BK = 64, HALF = 128, HTB = HALF * BK * 2, STAGE_BYTES = 8 * HTB, NXCD = 8, WGM = 8;
__host__ __device__ __forceinline__ int lds_byte(int r, int c) { const int st = (r >> 4) * 2 + (c >> 5), rr = r & 15, cc = c & 31, ob = rr * 64 + cc * 2; return st * 1024 + (ob ^ (((ob >> 9) & 1) << 5)); }
__host__ __device__ __forceinline__ void stage_rc(int b, int& R, int& C) { const int st = b / 1024, sb = b % 1024, swz = sb ^ (((sb >> 9) & 1) << 5); R = (st >> 1) * 16 + swz / 64; C = (st & 1) * 32 + (swz % 64) / 2; }
__host__ __device__ __forceinline__ int perm32(int rho) { const int n = rho >> 4, i = rho & 15; return 8 * (i >> 2) + 4 * n + (i & 3); }

struct Unit { int pm, pn; };
struct Gemm { const bf16_t* A; const bf16_t* Bt; int lda, ldb, K, tpg, goff; };

struct StaticOrder {
    int nM, nN, nwg, G, c;
    __device__ void init(int M, int N, int G_, int c_) { nM = M / BM; nN = N / BM; nwg = nM * nN; G = G_; c = c_; }
    __device__ bool next(int i, Unit& u) const {
        const long L = (long)i * G + c; if (L >= nwg) return false;
        int wgid = (int)L; { const int q = nwg / NXCD, r = nwg % NXCD, xcd = wgid % NXCD, off = wgid / NXCD; wgid = (xcd < r ? xcd * (q + 1) : r * (q + 1) + (xcd - r) * q) + off; }
        const int nig = WGM * nN, gid = wgid / nig, fm = gid * WGM, gsz = (nM - fm) < WGM ? (nM - fm) : WGM;
        u.pm = fm + ((wgid % nig) % gsz); u.pn = (wgid % nig) / gsz; return true;
    }
};

template <int ACT  > struct EpiBf16 {
    static constexpr bool PERM = true;
    bf16_t* O; int ldc;
    __device__ __forceinline__ void operator()(const f32x4 (&acc)[2][2][4][2], const Unit& u, int wr, int wc, int fr, int fq) const {
        const int row0 = u.pm * BM + wr * 64 + fr, col0 = u.pn * BM + wc * 32 + 8 * fq;
#pragma unroll
        for (int ai = 0; ai < 2; ++ai)
#pragma unroll
            for (int m = 0; m < 4; ++m) { bf16_t* rowp = O + (size_t)(row0 + ai * HALF + m * 16) * ldc + col0;
#pragma unroll
                for (int bj = 0; bj < 2; ++bj) { f32x4 v0 = acc[ai][bj][m][0], v1 = acc[ai][bj][m][1];
                    if (ACT == 1) {
#pragma unroll
                        for (int j = 0; j < 4; ++j) { const float a = fmaxf(v0[j], 0.f), b = fmaxf(v1[j], 0.f); v0[j] = a * a; v1[j] = b * b; }
                        asm volatile("" : "+v"(v0), "+v"(v1)); }
                    u32x4 w; w.x = cvt_pk_bf16(v0[0], v0[1]); w.y = cvt_pk_bf16(v0[2], v0[3]); w.z = cvt_pk_bf16(v1[0], v1[1]); w.w = cvt_pk_bf16(v1[2], v1[3]);
                    *(u32x4*)(rowp + bj * HALF) = w; }
                asm volatile("" ::: "memory"); }
    }
};
struct EpiInProj {
    static constexpr bool PERM = true;
    bf16_t* O; float* DT; const float* dt_bias;
    __device__ __forceinline__ void operator()(const f32x4 (&acc)[2][2][4][2], const Unit& u, int wr, int wc, int fr, int fq) const {
        const int row0 = u.pm * BM + wr * 64 + fr;
        if (u.pn < 40) {
            const int col0 = u.pn * BM + wc * 32 + 8 * fq;
#pragma unroll
            for (int ai = 0; ai < 2; ++ai)
#pragma unroll
                for (int m = 0; m < 4; ++m) { bf16_t* rowp = O + (size_t)(row0 + ai * HALF + m * 16) * ZXW + col0;
#pragma unroll
                    for (int bj = 0; bj < 2; ++bj) { const f32x4 v0 = acc[ai][bj][m][0], v1 = acc[ai][bj][m][1];
                        u32x4 w; w.x = cvt_pk_bf16(v0[0], v0[1]); w.y = cvt_pk_bf16(v0[2], v0[3]); w.z = cvt_pk_bf16(v1[0], v1[1]); w.w = cvt_pk_bf16(v1[2], v1[3]);
                        *(u32x4*)(rowp + bj * HALF) = w; } }
        } else if (wc < 2) {
            const int c0 = wc * 32 + 8 * fq;
            const f32x4 b0 = *(const f32x4*)(dt_bias + c0), b1 = *(const f32x4*)(dt_bias + c0 + 4);
#pragma unroll
            for (int ai = 0; ai < 2; ++ai)
#pragma unroll
                for (int m = 0; m < 4; ++m) { float* rowp = DT + (size_t)(row0 + ai * HALF + m * 16) * 64 + c0;
                    f32x4 v0 = acc[ai][0][m][0] + b0, v1 = acc[ai][0][m][1] + b1;
#pragma unroll
                    for (int j = 0; j < 4; ++j) { v0[j] = v0[j] > 20.f ? v0[j] : log1pf(__expf(v0[j])); v1[j] = v1[j] > 20.f ? v1[j] : log1pf(__expf(v1[j])); }
                    *(f32x4*)rowp = v0; *(f32x4*)(rowp + 4) = v1; }
        }
    }
};
template <int MODE> struct EpiF32 {
    static constexpr bool PERM = false;
    float* XF; const float* xin; const float* scale; const float* ssq; const bf16_t* PW;
    __device__ __forceinline__ void operator()(const f32x4 (&acc)[2][2][4][2], const Unit& u, int wr, int wc, int fr, int fq) const {
        const int row0 = u.pm * BM + wr * 64 + fr, col0 = u.pn * BM + wc * 32 + 4 * fq;
        f32x4 sc[2][2];
        if (MODE == 0) {
#pragma unroll
            for (int bj = 0; bj < 2; ++bj)
#pragma unroll
                for (int n = 0; n < 2; ++n) sc[bj][n] = *(const f32x4*)(scale + col0 + bj * HALF + n * 16);
        }
#pragma unroll
        for (int ai = 0; ai < 2; ++ai)
#pragma unroll
            for (int m = 0; m < 4; ++m) { const int row = row0 + ai * HALF + m * 16; const size_t off = (size_t)row * DM + col0;
                float rs = 1.f; if (MODE == 2) rs = 1.0f / sqrtf(ssq[row] * (1.0f / DIN) + RMS_EPS_F);
#pragma unroll
                for (int bj = 0; bj < 2; ++bj)
#pragma unroll
                    for (int n = 0; n < 2; ++n) { const size_t o = off + bj * HALF + n * 16; const f32x4 a = acc[ai][bj][m][n]; f32x4 r;
                        if (MODE == 0) { const f32x4 xv = *(const f32x4*)(xin + o); r = xv * ALPHA_F + a * sc[bj][n]; }
                        if (MODE == 1) { const f32x4 xv = *(const f32x4*)(XF + o); r = xv * ALPHA_F + a; }
                        if (MODE == 2) { const f32x4 xv = *(const f32x4*)(XF + o); r = xv * ALPHA_F + a * rs; }
                        if (MODE == 3) { const f32x4 xv = *(const f32x4*)(XF + o); const u32x2 pw = *(const u32x2*)(PW + o);
                            r[0] = xv[0] + fast_sigmoid(a[0]) * bf_lo(pw.x); r[1] = xv[1] + fast_sigmoid(a[1]) * bf_hi(pw.x);
                            r[2] = xv[2] + fast_sigmoid(a[2]) * bf_lo(pw.y); r[3] = xv[3] + fast_sigmoid(a[3]) * bf_hi(pw.y); }
                        *(f32x4*)(XF + o) = r; }
                asm volatile("" ::: "memory"); }
    }
};

template <class Epi>
__device__ __forceinline__ void gemm_phase(LAS unsigned char* lds, const Gemm g, const StaticOrder& S, const Epi& E) {
    const int tid = launder((int)threadIdx.x), wid = __builtin_amdgcn_readfirstlane(tid >> 6), lane = tid & 63, wr = wid >> 2, wc = wid & 3, fr = lane & 15, fq = lane >> 4;
    int nt = g.K / BK; asm volatile("" : "+s"(nt));
    unsigned voffA[2], voffB[2];
#pragma unroll
    for (int i = 0; i < 2; ++i) { int R, C; stage_rc(tid * 16 + i * 8192, R, C); const int Rb = Epi::PERM ? ((R & ~31) + perm32(R & 31)) : R;
        voffA[i] = (unsigned)(R * g.lda + C) * 2u; voffB[i] = (unsigned)(Rb * g.ldb + C) * 2u; }
    const size_t kstep = (size_t)(BK * 2);
    const size_t hstepA = (size_t)HALF * g.lda * 2, hstepB = (size_t)HALF * g.ldb * 2;
    const unsigned ldsw = (unsigned)wid * 1024u;
    const int aoff = lds_byte(wr * 64 + fr, fq * 8), boff = lds_byte(wc * 32 + fr, fq * 8);
#define PG8_APTR(u) ((const char*)g.A + (size_t)(u).pm * 2 * hstepA + (size_t)((u).pn / g.tpg) * (size_t)g.goff * 2)
#define PG8_BPTR(u) ((const char*)g.Bt + (size_t)(u).pn * 2 * hstepB)
#define PG8_SA(b, h) (((b) * 2 + (h)) * HTB)
#define PG8_SB(b, h) ((4 + (b) * 2 + (h)) * HTB)
#define PG8_STAGE(bufoff, gbase, voff) do { _Pragma("unroll") for (int _i = 0; _i < 2; ++_i) \
        __builtin_amdgcn_global_load_lds((const unsigned*)((const char*)(gbase) + (voff)[_i]), (LAS unsigned*)(lds + (bufoff) + ldsw + _i * 8192), 16, 0, 0); } while (0)
#define PG8_LDA(dst, b, h) do { _Pragma("unroll") for (int m = 0; m < 4; ++m) _Pragma("unroll") for (int k = 0; k < 2; ++k) dst[m][k] = *(const LAS bf16x8*)(lds + PG8_SA(b, h) + aoff + m * 2048 + k * 1024); } while (0)
#define PG8_LDB(dst, b, h) do { _Pragma("unroll") for (int n = 0; n < 2; ++n) _Pragma("unroll") for (int k = 0; k < 2; ++k) dst[n][k] = *(const LAS bf16x8*)(lds + PG8_SB(b, h) + boff + n * 2048 + k * 1024); } while (0)
#define PG8_MMA(ai, bj, At, Bt) do { __builtin_amdgcn_s_setprio(1); _Pragma("unroll") for (int m = 0; m < 4; ++m) _Pragma("unroll") for (int n = 0; n < 2; ++n) _Pragma("unroll") for (int k = 0; k < 2; ++k) \
        acc[ai][bj][m][n] = __builtin_amdgcn_mfma_f32_16x16x32_bf16(Bt[n][k], At[m][k], acc[ai][bj][m][n], 0, 0, 0); __builtin_amdgcn_s_setprio(0); } while (0)
#define PG8_WAIT_V(n) asm volatile("s_waitcnt vmcnt(" #n ")" ::: "memory")
#define PG8_WAIT_L(n) asm volatile("s_waitcnt lgkmcnt(" #n ")" ::: "memory")
#define PG8_BAR __builtin_amdgcn_s_barrier()
#define PG8_SCHED __builtin_amdgcn_sched_barrier(0)
    Unit cur, nxt; int ui = 0;
    if (!S.next(0, cur)) return;
    f32x4 acc[2][2][4][2];
#pragma unroll
    for (int a = 0; a < 2; ++a)
#pragma unroll
        for (int b = 0; b < 2; ++b)
#pragma unroll
            for (int m = 0; m < 4; ++m)
#pragma unroll
                for (int n = 0; n < 2; ++n) acc[a][b][m][n] = (f32x4){0.f, 0.f, 0.f, 0.f};
    bf16x8 At[4][2], B0[2][2], B1[2][2];
    const char* cA = PG8_APTR(cur); const char* cB = PG8_BPTR(cur);
    PG8_STAGE(PG8_SB(0, 0), cB, voffB); PG8_STAGE(PG8_SB(0, 1), cB + hstepB, voffB); PG8_STAGE(PG8_SA(0, 0), cA, voffA); PG8_STAGE(PG8_SA(0, 1), cA + hstepA, voffA);
    if (wr == 1) PG8_BAR;
    PG8_WAIT_V(2); PG8_BAR;
    PG8_STAGE(PG8_SB(1, 0), cB + kstep, voffB); PG8_STAGE(PG8_SA(1, 0), cA + kstep, voffA); PG8_STAGE(PG8_SB(1, 1), cB + hstepB + kstep, voffB);
    PG8_WAIT_V(6); PG8_BAR;
    for (;;) {
        const bool has_next = S.next(ui + 1, nxt);
        const char* nA = has_next ? PG8_APTR(nxt) : cA; const char* nB = has_next ? PG8_BPTR(nxt) : cB;
        for (int t = 0; t < nt; t += 2) {
            const bool last = (t == nt - 2);
            const char* a1 = cA + (size_t)(t + 1) * kstep;
            const char* a2 = last ? nA : cA + (size_t)(t + 2) * kstep; const char* b2 = last ? nB : cB + (size_t)(t + 2) * kstep;
            const char* a3 = a2 + kstep; const char* b3 = b2 + kstep;
            PG8_LDB(B0, 0, 0); PG8_LDB(B1, 0, 1); PG8_SCHED; PG8_LDA(At, 0, 0); PG8_STAGE(PG8_SA(1, 1), a1 + hstepA, voffA);
            PG8_WAIT_V(8); PG8_WAIT_L(0); PG8_BAR; PG8_MMA(0, 0, At, B0); PG8_MMA(0, 1, At, B1); PG8_BAR; PG8_SCHED;
            PG8_LDA(At, 0, 1); PG8_STAGE(PG8_SB(0, 0), b2, voffB); PG8_STAGE(PG8_SB(0, 1), b2 + hstepB, voffB); PG8_STAGE(PG8_SA(0, 0), a2, voffA);
            PG8_WAIT_V(8); PG8_WAIT_L(0); PG8_BAR; PG8_MMA(1, 0, At, B0); PG8_MMA(1, 1, At, B1); PG8_BAR; PG8_SCHED;
            PG8_LDB(B0, 1, 0); PG8_LDB(B1, 1, 1); PG8_SCHED; PG8_LDA(At, 1, 0); PG8_STAGE(PG8_SA(0, 1), a2 + hstepA, voffA);
            PG8_WAIT_V(8); PG8_WAIT_L(0); PG8_BAR; PG8_MMA(0, 0, At, B0); PG8_MMA(0, 1, At, B1); PG8_BAR; PG8_SCHED;
            PG8_LDA(At, 1, 1); PG8_STAGE(PG8_SB(1, 0), b3, voffB); PG8_STAGE(PG8_SB(1, 1), b3 + hstepB, voffB); PG8_STAGE(PG8_SA(1, 0), a3, voffA);
            PG8_WAIT_V(8); PG8_WAIT_L(0); PG8_BAR; PG8_MMA(1, 0, At, B0); PG8_MMA(1, 1, At, B1); PG8_BAR; PG8_SCHED;
        }
        if (wr == 0) PG8_BAR;
        E(acc, cur, wr, wc, fr, fq);
        if (!has_next) break;
#pragma unroll
        for (int a = 0; a < 2; ++a)
#pragma unroll
            for (int b = 0; b < 2; ++b)
#pragma unroll
                for (int m = 0; m < 4; ++m)
#pragma unroll
                    for (int n = 0; n < 2; ++n) acc[a][b][m][n] = (f32x4){0.f, 0.f, 0.f, 0.f};
        cur = nxt; cA = nA; cB = nB; ++ui;
        if (wr == 1) PG8_BAR;
    }
    PG8_WAIT_V(0);
    PG8_BAR;
#undef PG8_APTR
#undef PG8_BPTR
#undef PG8_SA
#undef PG8_SB
#undef PG8_STAGE
#undef PG8_LDA
#undef PG8_LDB
#undef PG8_MMA
#undef PG8_WAIT_V
#undef PG8_WAIT_L
#undef PG8_BAR
#undef PG8_SCHED
}
}

struct Args {
    const float* x; const float* p; const float* pool_w; const float* pool_scale; const float* ssm_in_w; const float* conv_w; const float* conv_b;
    const float* dt_bias; const float* a_log; const float* d_skip; const float* norm_w; const float* out_w; const float* w1; const float* w2;
    const float* ln_g; const float* ln_b; const float* ple_w; const float* gate_w;
    float* out; unsigned char* ws;
};

typedef __attribute__((address_space(4))) const Args CArgs;
__device__ __forceinline__ CArgs* kargs() { CArgs* p = (CArgs*)__builtin_amdgcn_kernarg_segment_ptr(); asm volatile("" : "+s"(p)); return p; }
#define KA(f) (kargs()->f)

__device__ __forceinline__ void transpose_item(const float* W, int K, int N, bf16_t* WT, int row_off, LAS float* scr, int item, int lane) {
    const int nblk = N / 32, kb = item / nblk, nb = item % nblk, k0 = 64 * kb, n0 = 32 * nb;
#pragma unroll 8
    for (int i = 0; i < 32; ++i) { const int kk = 2 * i + (lane >> 5); scr[kk * 33 + (lane & 31)] = W[(size_t)(k0 + kk) * N + n0 + (lane & 31)]; }
    LDS_WAIT();
    const int c = lane & 7;
#pragma unroll
    for (int j = 0; j < 4; ++j) { const int n = (lane >> 3) + 8 * j; const LAS float* s = scr + (8 * c) * 33 + n;
        u32x4 o; o.x = cvt_pk_bf16(s[0 * 33], s[1 * 33]); o.y = cvt_pk_bf16(s[2 * 33], s[3 * 33]); o.z = cvt_pk_bf16(s[4 * 33], s[5 * 33]); o.w = cvt_pk_bf16(s[6 * 33], s[7 * 33]);
        *(u32x4*)(WT + (size_t)(row_off + n0 + n) * K + k0 + 8 * c) = o; }
    LDS_WAIT();
}
__device__ __forceinline__ void transpose_matrix(const float* W, int K, int N, bf16_t* WT, int row_off, LAS float* scr, int gw, int ngw, int lane) {
    const int nitems = (K / 64) * (N / 32);
    for (int it = gw; it < nitems; it += ngw) transpose_item(W, K, N, WT, row_off, scr, it, lane);
}
__device__ __forceinline__ void cvt_rows(const float* src, bf16_t* dst, size_t n4, size_t gt, size_t ngt) {
    for (size_t i = gt; i < n4; i += ngt) { const f32x4 v = ((const f32x4*)src)[i]; u32x2 w; w.x = cvt_pk_bf16(v[0], v[1]); w.y = cvt_pk_bf16(v[2], v[3]); ((u32x2*)dst)[i] = w; }
}
__device__ __forceinline__ void pool_phase(const float* x, bf16_t* PB, int gt, int ngt) {
    for (int it = gt; it < NB * 128 * 512; it += ngt) {
        const int c4 = it & 511, seg = (it >> 9) & 127, b = it >> 16;
        const int win = 2 << (c4 >> 7);
        const f32x4* xp = (const f32x4*)(x + (size_t)b * SEQL * DM) + c4;
        u32x2* op = (u32x2*)(PB + (size_t)b * SEQL * DM) + c4;
        const int t0 = seg * 16;
        f32x4 s = (f32x4){0.f, 0.f, 0.f, 0.f};
        for (int k = 1; k < win; ++k) { const int t = t0 - k; if (t >= 0) s += xp[(size_t)t * 512]; }
        for (int r = 0; r < 16; ++r) {
            const int t = t0 + r;
            const f32x4 v = xp[(size_t)t * 512];
            s += v;
            const float inv = 1.0f / (float)((t + 1) < win ? (t + 1) : win);
            const f32x4 o = s * inv - v;
            u32x2 w; w.x = cvt_pk_bf16(o[0], o[1]); w.y = cvt_pk_bf16(o[2], o[3]);
            op[(size_t)t * 512] = w;
            const int tp = t - win + 1; if (tp >= 0) s -= xp[(size_t)tp * 512];
        }
    }
}
__device__ __forceinline__ void ln_phase(float* XF, bf16_t* XB, const float* g, const float* bta, int gw, int ngw, int lane) {
    f32x4 gv[8], bv[8];
#pragma unroll
    for (int j = 0; j < 8; ++j) { gv[j] = ((const f32x4*)g)[lane + 64 * j]; bv[j] = ((const f32x4*)bta)[lane + 64 * j]; }
    for (int row = gw; row < MROWS; row += ngw) {
        f32x4* xr = (f32x4*)(XF + (size_t)row * DM) + lane;
        f32x4 v[8]; float s = 0.f;
#pragma unroll
        for (int j = 0; j < 8; ++j) { v[j] = xr[64 * j]; s += (v[j][0] + v[j][1]) + (v[j][2] + v[j][3]); }
        const float mean = wave_sum(s) * (1.0f / DM); float s2 = 0.f;
#pragma unroll
        for (int j = 0; j < 8; ++j) { v[j] = v[j] - mean; s2 += (v[j][0] * v[j][0] + v[j][1] * v[j][1]) + (v[j][2] * v[j][2] + v[j][3] * v[j][3]); }
        const float rstd = 1.0f / sqrtf(wave_sum(s2) * (1.0f / DM) + LN_EPS_F);
        u32x2* ob = (u32x2*)(XB + (size_t)row * DM) + lane;
#pragma unroll
        for (int j = 0; j < 8; ++j) { const f32x4 y = v[j] * rstd * gv[j] + bv[j]; xr[64 * j] = y;
            u32x2 w; w.x = cvt_pk_bf16(y[0], y[1]); w.y = cvt_pk_bf16(y[2], y[3]); ob[64 * j] = w; }
    }
}

constexpr int SST = 272;
constexpr int L_SC = 0, L_SB = 34816, L_SM = 69632, L_SXT = 104448, L_SST = 121856, L_SX = 139264, SXS = 144, L_ACS = 157696, L_SSD_END = 158208;
static_assert(L_SSD_END <= LDS_BYTES, "SSD LDS map");

#define UNPK(dst, SRC_) do { dst[0] = bf_lo((SRC_).x); dst[1] = bf_hi((SRC_).x); dst[2] = bf_lo((SRC_).y); dst[3] = bf_hi((SRC_).y); dst[4] = bf_lo((SRC_).z); dst[5] = bf_hi((SRC_).z); dst[6] = bf_lo((SRC_).w); dst[7] = bf_hi((SRC_).w); } while (0)
__device__ __forceinline__ void ssd_phase(LAS unsigned char* lds, bf16_t* zx, const float* DTp, const float* conv_w, const float* conv_b, const float* a_log,
                                          const float* d_skip, const float* norm_w, float* ssq) {
    const int tid = launder((int)threadIdx.x), wid = __builtin_amdgcn_readfirstlane(tid >> 6), lane = tid & 63, fr = lane & 15, fq = lane >> 4;
    const int bx = blockIdx.x, xcd = bx & 7, slot = bx >> 3;
    LAS float* sAcs = (LAS float*)(lds + L_ACS);
    for (int round = 0; round < 2; ++round) {
        int b, h;
        if (gridDim.x == 256) { const int q = ((slot >> 3) + 4 * round) * 8 + xcd; b = q >> 3; h = (q & 7) * 8 + (slot & 7); }
        else { const int item = bx + round * (int)gridDim.x; if (item >= NB * NHEAD) break; b = item >> 6; h = item & 63; }
        const int g = h >> 3;
        const float a_h = -__expf(a_log[h]), d_h = d_skip[h];
        const int cg = tid % 40, rseg = tid / 40;
        const bool conv_thr = tid < 320;
        int ch = 0;
        if (cg < 8) ch = h * 64 + cg * 8; else if (cg < 24) ch = DIN + g * 128 + (cg - 8) * 8; else ch = DIN + NGRP * DSTATE + g * 128 + (cg - 24) * 8;
        float cw[4][8], cb[8];
        if (conv_thr) {
#pragma unroll
            for (int k = 0; k < 4; ++k) { const f32x4 w0 = *(const f32x4*)(conv_w + k * CONVD + ch), w1 = *(const f32x4*)(conv_w + k * CONVD + ch + 4);
#pragma unroll
                for (int i = 0; i < 4; ++i) { cw[k][i] = w0[i]; cw[k][4 + i] = w1[i]; } }
            const f32x4 b0 = *(const f32x4*)(conv_b + ch), b1 = *(const f32x4*)(conv_b + ch + 4);
#pragma unroll
            for (int i = 0; i < 4; ++i) { cb[i] = b0[i]; cb[4 + i] = b1[i]; }
        }
        f32x4 st[4];
#pragma unroll
        for (int i = 0; i < 4; ++i) st[i] = (f32x4){0.f, 0.f, 0.f, 0.f};
        __syncthreads();
        for (int i = tid; i < 64 * SST / 4; i += 512) ((LAS unsigned*)(lds + L_SST))[i] = 0u;
        for (int c = 0; c < NCHUNK; ++c) {
            __syncthreads();
            if (conv_thr) {
                const int tseg = c * CHUNKL + rseg * 16;
                const bf16_t* src = zx + ((size_t)b * SEQL) * ZXW + DIN + ch;
                float u0[8], u1[8], u2[8];
                {
                    u32x4 hal[3];
#pragma unroll
                    for (int r = 0; r < 3; ++r) { const int t = tseg + r - 3; hal[r] = (t >= 0) ? *(const u32x4*)(src + (size_t)t * ZXW) : (u32x4){0u, 0u, 0u, 0u}; }
                    UNPK(u0, hal[0]); UNPK(u1, hal[1]); UNPK(u2, hal[2]);
                }
#pragma unroll 1
                for (int hf = 0; hf < 2; ++hf) {
                    u32x4 raw[8];
#pragma unroll
                    for (int r = 0; r < 8; ++r) raw[r] = *(const u32x4*)(src + (size_t)(tseg + hf * 8 + r) * ZXW);
                    float dtv[8];
                    if (cg < 8) {
#pragma unroll
                        for (int r = 0; r < 8; ++r) dtv[r] = DTp[((size_t)b * SEQL + tseg + hf * 8 + r) * 64 + h];
                    }
#pragma unroll
                    for (int r = 0; r < 8; ++r) {
                        float cu[8], v[8]; UNPK(cu, raw[r]);
#pragma unroll
                        for (int i = 0; i < 8; ++i) { const float a = cb[i] + cw[0][i] * u0[i] + cw[1][i] * u1[i] + cw[2][i] * u2[i] + cw[3][i] * cu[i]; v[i] = fast_silu(a); u0[i] = u1[i]; u1[i] = u2[i]; u2[i] = cu[i]; }
                        const int l = rseg * 16 + hf * 8 + r;
                        u32x4 w; w.x = cvt_pk_bf16(v[0], v[1]); w.y = cvt_pk_bf16(v[2], v[3]); w.z = cvt_pk_bf16(v[4], v[5]); w.w = cvt_pk_bf16(v[6], v[7]);
                        if (cg >= 24) *(LAS u32x4*)(lds + L_SC + l * SST + (cg - 24) * 16) = w;
                        else if (cg >= 8) *(LAS u32x4*)(lds + L_SB + l * SST + (cg - 8) * 16) = w;
                        else {
                            *(LAS u32x4*)(lds + L_SX + l * SXS + cg * 16) = w;
                            const float d = dtv[r];
#pragma unroll
                            for (int i = 0; i < 8; i += 2) { const unsigned pk = cvt_pk_bf16(v[i] * d, v[i + 1] * d);
                                *(LAS unsigned short*)(lds + L_SXT + (cg * 8 + i) * SST + l * 2) = (unsigned short)(pk & 0xffffu);
                                *(LAS unsigned short*)(lds + L_SXT + (cg * 8 + i + 1) * SST + l * 2) = (unsigned short)(pk >> 16); }
                        }
                    }
                }
            } else if (wid == 7) {
                const size_t r0 = (size_t)b * SEQL + c * CHUNKL + 2 * lane;
                const float da0 = DTp[r0 * 64 + h] * a_h, da1 = DTp[(r0 + 1) * 64 + h] * a_h;
                float s = da0 + da1;
#pragma unroll
                for (int o = 1; o < 64; o <<= 1) { const float t = __shfl_up(s, o); if (lane >= o) s += t; }
                sAcs[2 * lane] = s - da1; sAcs[2 * lane + 1] = s;
            }
            __syncthreads();
            const int l0 = wid * 16, kbmax = wid >> 1;
            {
                bf16x8 yc[4];
#pragma unroll
                for (int kb = 0; kb < 4; ++kb) yc[kb] = *(const LAS bf16x8*)(lds + L_SC + (l0 + fr) * SST + kb * 64 + fq * 16);
                const float acs_l = sAcs[l0 + fr];
                for (int stl = 0; stl <= 2 * kbmax + 1; ++stl) {
                    f32x4 a = (f32x4){0.f, 0.f, 0.f, 0.f};
                    if (stl <= wid) {
#pragma unroll
                        for (int kb = 0; kb < 4; ++kb) { const bf16x8 xb = *(const LAS bf16x8*)(lds + L_SB + (stl * 16 + fr) * SST + kb * 64 + fq * 16);
                            a = __builtin_amdgcn_mfma_f32_16x16x32_bf16(xb, yc[kb], a, 0, 0, 0); }
                        const f32x4 as = *(const LAS f32x4*)(lds + L_ACS + (stl * 16 + 4 * fq) * 4);
#pragma unroll
                        for (int r = 0; r < 4; ++r) { const int s = stl * 16 + 4 * fq + r; a[r] = (s <= l0 + fr) ? a[r] * __expf(acs_l - as[r]) : 0.f; }
                    }
                    u32x2 w; w.x = cvt_pk_bf16(a[0], a[1]); w.y = cvt_pk_bf16(a[2], a[3]);
                    *(LAS u32x2*)(lds + L_SM + (l0 + fr) * SST + (stl * 16 + 4 * fq) * 2) = w;
                }
            }
            __syncthreads();
            {
                f32x4 yd[4], yo[4];
#pragma unroll
                for (int i = 0; i < 4; ++i) { yd[i] = (f32x4){0.f, 0.f, 0.f, 0.f}; yo[i] = (f32x4){0.f, 0.f, 0.f, 0.f}; }
                for (int kb = 0; kb <= kbmax; ++kb) { const bf16x8 ym = *(const LAS bf16x8*)(lds + L_SM + (l0 + fr) * SST + kb * 64 + fq * 16);
#pragma unroll
                    for (int pt = 0; pt < 4; ++pt) { const bf16x8 xx = *(const LAS bf16x8*)(lds + L_SXT + (pt * 16 + fr) * SST + kb * 64 + fq * 16);
                        yd[pt] = __builtin_amdgcn_mfma_f32_16x16x32_bf16(xx, ym, yd[pt], 0, 0, 0); } }
#pragma unroll
                for (int kb = 0; kb < 4; ++kb) { const bf16x8 yc = *(const LAS bf16x8*)(lds + L_SC + (l0 + fr) * SST + kb * 64 + fq * 16);
#pragma unroll
                    for (int pt = 0; pt < 4; ++pt) { const bf16x8 xs = *(const LAS bf16x8*)(lds + L_SST + (pt * 16 + fr) * SST + kb * 64 + fq * 16);
                        yo[pt] = __builtin_amdgcn_mfma_f32_16x16x32_bf16(xs, yc, yo[pt], 0, 0, 0); } }
                const int l = l0 + fr; const float el = __expf(sAcs[l]);
                const size_t row = (size_t)b * SEQL + c * CHUNKL + l;
                bf16_t* zp = zx + row * ZXW + h * 64 + 4 * fq;
                const float* nwp = norm_w + h * 64 + 4 * fq;
                float sq = 0.f;
#pragma unroll
                for (int pt = 0; pt < 4; ++pt) {
                    const u32x2 xw = *(const LAS u32x2*)(lds + L_SX + l * SXS + (pt * 16 + 4 * fq) * 2);
                    const u32x2 zw = *(const u32x2*)(zp + pt * 16);
                    const f32x4 nw = *(const f32x4*)(nwp + pt * 16);
                    float y0 = yd[pt][0] + el * yo[pt][0] + d_h * bf_lo(xw.x), y1 = yd[pt][1] + el * yo[pt][1] + d_h * bf_hi(xw.x);
                    float y2 = yd[pt][2] + el * yo[pt][2] + d_h * bf_lo(xw.y), y3 = yd[pt][3] + el * yo[pt][3] + d_h * bf_hi(xw.y);
                    y0 *= fast_silu(bf_lo(zw.x)); y1 *= fast_silu(bf_hi(zw.x)); y2 *= fast_silu(bf_lo(zw.y)); y3 *= fast_silu(bf_hi(zw.y));
                    sq += (y0 * y0 + y1 * y1) + (y2 * y2 + y3 * y3);
                    u32x2 w; w.x = cvt_pk_bf16(y0 * nw[0], y1 * nw[1]); w.y = cvt_pk_bf16(y2 * nw[2], y3 * nw[3]);
                    *(u32x2*)(zp + pt * 16) = w;
                }
                sq += __shfl_xor(sq, 16); sq += __shfl_xor(sq, 32);
                if (fq == 0) atomicAdd(ssq + row, sq);
            }
            __syncthreads();
            const float acs_end = sAcs[CHUNKL - 1];
#pragma unroll
            for (int i = 0; i < 4; ++i) { const int item = tid + 512 * i, l = item & 127, ng = item >> 7;
                const float dec = __expf(acs_end - sAcs[l]);
                const u32x4 w = *(const LAS u32x4*)(lds + L_SB + l * SST + ng * 16);
                float v[8]; UNPK(v, w);
#pragma unroll
                for (int j = 0; j < 8; j += 2) { const unsigned pk = cvt_pk_bf16(v[j] * dec, v[j + 1] * dec);
                    *(LAS unsigned short*)(lds + L_SM + (ng * 8 + j) * SST + l * 2) = (unsigned short)(pk & 0xffffu);
                    *(LAS unsigned short*)(lds + L_SM + (ng * 8 + j + 1) * SST + l * 2) = (unsigned short)(pk >> 16); } }
            __syncthreads();
            {
                const float ce = __expf(acs_end);
#pragma unroll
                for (int pt = 0; pt < 4; ++pt) st[pt] = st[pt] * ce;
#pragma unroll
                for (int kb = 0; kb < 4; ++kb) { const bf16x8 xb = *(const LAS bf16x8*)(lds + L_SM + (l0 + fr) * SST + kb * 64 + fq * 16);
#pragma unroll
                    for (int pt = 0; pt < 4; ++pt) { const bf16x8 yx = *(const LAS bf16x8*)(lds + L_SXT + (pt * 16 + fr) * SST + kb * 64 + fq * 16);
                        st[pt] = __builtin_amdgcn_mfma_f32_16x16x32_bf16(xb, yx, st[pt], 0, 0, 0); } }
#pragma unroll
                for (int pt = 0; pt < 4; ++pt) { u32x2 w; w.x = cvt_pk_bf16(st[pt][0], st[pt][1]); w.y = cvt_pk_bf16(st[pt][2], st[pt][3]);
                    *(LAS u32x2*)(lds + L_SST + (pt * 16 + fr) * SST + (l0 + 4 * fq) * 2) = w; }
            }
        }
#undef UNPK
    }
    __syncthreads();
}

#ifdef NO_GEMM
#define GEMM_CALL(l, g, S, E) do { (void)g; (void)S; (void)E; } while (0)
#else
#define GEMM_CALL(l, g, S, E) pg8::gemm_phase(l, g, S, E)
#endif
#if defined(ONLY_GEMM) && ONLY_GEMM != 1
#define GEMM_CALL1(l, g, S, E) do { (void)g; (void)S; (void)E; } while (0)
#else
#define GEMM_CALL1(l, g, S, E) GEMM_CALL(l, g, S, E)
#endif
#if defined(ONLY_GEMM) && ONLY_GEMM != 2
#define GEMM_CALL2(l, g, S, E) do { (void)g; (void)S; (void)E; } while (0)
#else
#define GEMM_CALL2(l, g, S, E) GEMM_CALL(l, g, S, E)
#endif
#if defined(ONLY_GEMM) && ONLY_GEMM != 3
#define GEMM_CALL3(l, g, S, E) do { (void)g; (void)S; (void)E; } while (0)
#else
#define GEMM_CALL3(l, g, S, E) GEMM_CALL(l, g, S, E)
#endif
#if defined(ONLY_GEMM) && ONLY_GEMM != 4
#define GEMM_CALL4(l, g, S, E) do { (void)g; (void)S; (void)E; } while (0)
#else
#define GEMM_CALL4(l, g, S, E) GEMM_CALL(l, g, S, E)
#endif
#if defined(ONLY_GEMM) && ONLY_GEMM != 5
#define GEMM_CALL5(l, g, S, E) do { (void)g; (void)S; (void)E; } while (0)
#else
#define GEMM_CALL5(l, g, S, E) GEMM_CALL(l, g, S, E)
#endif
#if defined(ONLY_GEMM) && ONLY_GEMM != 6
#define GEMM_CALL6(l, g, S, E) do { (void)g; (void)S; (void)E; } while (0)
#else
#define GEMM_CALL6(l, g, S, E) GEMM_CALL(l, g, S, E)
#endif
#if defined(ONLY_GEMM) && ONLY_GEMM != 7
#define GEMM_CALL7(l, g, S, E) do { (void)g; (void)S; (void)E; } while (0)
#else
#define GEMM_CALL7(l, g, S, E) GEMM_CALL(l, g, S, E)
#endif
__global__ void __launch_bounds__(512, 2) fwd_megakernel(Args a) {
    extern __shared__ __attribute__((aligned(16))) unsigned char lds_raw[];
    LAS unsigned char* lds = (LAS unsigned char*)lds_raw;
    cg::grid_group grid = cg::this_grid();
    const int G = gridDim.x, ngw = G * 8, ngt = G * 512;
    volatile LAS unsigned* barst = (volatile LAS unsigned*)(lds + L_BARST);
    if (threadIdx.x < 2) barst[threadIdx.x] = 0u;
    if (blockIdx.x == 0) for (int i = threadIdx.x; i < XCD_BAR_WORDS; i += 512) ((unsigned*)(KA(ws) + WS_BAR))[i] = 0u;
    int first_sync = 1;
#define GRID_SYNC() do { if (first_sync) { grid.sync(); xcd_barrier_post((unsigned*)(KA(ws) + WS_BAR)); first_sync = 0; } else xcd_barrier((unsigned*)(KA(ws) + WS_BAR), barst); } while (0)
#define SSQ ((float*)(KA(ws) + WS_SSQ))
#define W1t ((bf16_t*)(KA(ws) + WS_W + W_W1))
#define W2t ((bf16_t*)(KA(ws) + WS_W + W_W2))
#define WGt ((bf16_t*)(KA(ws) + WS_W + W_GATE))
#define WPt ((bf16_t*)(KA(ws) + WS_W + W_PLE))
#define WAt ((bf16_t*)(KA(ws) + WS_W + W_A))
#define WOt ((bf16_t*)(KA(ws) + WS_W + W_OUT))
#define XB ((bf16_t*)(KA(ws) + WS_XB))
#define PBF ((bf16_t*)(KA(ws) + WS_PBF))
#define DT ((float*)(KA(ws) + WS_DT))
#define BIG ((bf16_t*)(KA(ws) + WS_BIG))
#define PW ((bf16_t*)(KA(ws) + WS_BIG + BIG_PW))
#define XF (KA(out))

    for (int layer = 0; layer < 2; ++layer) {
        const int tid = launder((int)threadIdx.x), lane = tid & 63, wave = __builtin_amdgcn_readfirstlane(tid >> 6);
        const int gw = blockIdx.x * 8 + wave, gt = blockIdx.x * 512 + tid;
        LAS float* scr = (LAS float*)(lds + wave * 16384);
#ifndef NO_THIN
        transpose_matrix(KA(w1) + (size_t)layer * DM * DFF, DM, DFF, W1t, 0, scr, gw, ngw, lane);
        transpose_matrix(KA(w2) + (size_t)layer * DFF * DM, DFF, DM, W2t, 0, scr, gw, ngw, lane);
        transpose_matrix(KA(gate_w) + (size_t)layer * DM * DM, DM, DM, WGt, 0, scr, gw, ngw, lane);
        transpose_matrix(KA(ple_w) + (size_t)layer * PLED * DM, PLED, DM, WPt, 0, scr, gw, ngw, lane);
        if (layer == 0) {
            for (int gi = 0; gi < 4; ++gi) transpose_matrix(KA(pool_w) + (size_t)gi * 512 * 512, 512, 512, WAt, gi * 512, scr, gw, ngw, lane);
            pool_phase(KA(x), BIG, gt, ngt);
            cvt_rows(KA(p), PBF, (size_t)2 * MROWS * PLED / 4, gt, ngt);
        } else {
            transpose_matrix(KA(ssm_in_w), DM, NIN, WAt, 0, scr, gw, ngw, lane);
            transpose_matrix(KA(out_w), DIN, DM, WOt, 0, scr, gw, ngw, lane);
            cvt_rows(XF, XB, (size_t)MROWS * DM / 4, gt, ngt);
            for (int i = gt; i < MROWS; i += ngt) SSQ[i] = 0.f;
        }
#endif
        GRID_SYNC();
        if (layer == 0) {
            pg8::Gemm g{BIG, WAt, DM, 512, 512, 2, 512}; pg8::StaticOrder S; S.init(MROWS, DM, G, (int)blockIdx.x);
            pg8::EpiF32<0> E{XF, KA(x), KA(pool_scale), nullptr, nullptr};
            GEMM_CALL1(lds, g, S, E);
            GRID_SYNC();
        } else {
            { pg8::Gemm g{XB, WAt, DM, DM, DM, 1 << 20, 0}; pg8::StaticOrder S; S.init(MROWS, NINP, G, (int)blockIdx.x);
              pg8::EpiInProj E{BIG, DT, KA(dt_bias)};
              GEMM_CALL2(lds, g, S, E); }
            GRID_SYNC();
#ifndef NO_SSD
            ssd_phase(lds, BIG, DT, KA(conv_w), KA(conv_b), KA(a_log), KA(d_skip), KA(norm_w), SSQ);
#endif
            GRID_SYNC();
            { pg8::Gemm g{BIG, WOt, ZXW, DIN, DIN, 1 << 20, 0}; pg8::StaticOrder S; S.init(MROWS, DM, G, (int)blockIdx.x);
              pg8::EpiF32<2> E{XF, nullptr, nullptr, SSQ, nullptr};
              GEMM_CALL3(lds, g, S, E); }
            GRID_SYNC();
        }
#ifndef NO_THIN
        ln_phase(XF, XB, KA(ln_g) + (size_t)(layer * 2 + 0) * DM, KA(ln_b) + (size_t)(layer * 2 + 0) * DM, gw, ngw, lane);
#endif
        GRID_SYNC();
        { pg8::Gemm g{PBF + (size_t)layer * MROWS * PLED, WPt, PLED, PLED, PLED, 1 << 20, 0}; pg8::StaticOrder S; S.init(MROWS, DM, G, (int)blockIdx.x);
          pg8::EpiBf16<0> E{PW, DM};
          GEMM_CALL4(lds, g, S, E); }
        { pg8::Gemm g{XB, W1t, DM, DM, DM, 1 << 20, 0}; pg8::StaticOrder S; S.init(MROWS, DFF, G, (int)blockIdx.x);
          pg8::EpiBf16<1> E{BIG, DFF};
          GEMM_CALL5(lds, g, S, E); }
        GRID_SYNC();
        { pg8::Gemm g{BIG, W2t, DFF, DFF, DFF, 1 << 20, 0}; pg8::StaticOrder S; S.init(MROWS, DM, G, (int)blockIdx.x);
          pg8::EpiF32<1> E{XF, nullptr, nullptr, nullptr, nullptr};
          GEMM_CALL6(lds, g, S, E); }
        GRID_SYNC();
#ifndef NO_THIN
        ln_phase(XF, XB, KA(ln_g) + (size_t)(layer * 2 + 1) * DM, KA(ln_b) + (size_t)(layer * 2 + 1) * DM, gw, ngw, lane);
#endif
        GRID_SYNC();
        { pg8::Gemm g{XB, WGt, DM, DM, DM, 1 << 20, 0}; pg8::StaticOrder S; S.init(MROWS, DM, G, (int)blockIdx.x);
          pg8::EpiF32<3> E{XF, nullptr, nullptr, nullptr, PW};
          GEMM_CALL7(lds, g, S, E); }
        if (layer == 0) GRID_SYNC();
    }
}

extern "C" void kernel_launch(void* const* d_in, const int* in_sizes, int n_in, void* d_out, int out_size, void* d_ws, size_t ws_size, hipStream_t stream) {
    static int grid = 0;
    if (grid == 0) {
        if (n_in != 18 || in_sizes[0] != MROWS * DM || out_size != MROWS * DM || ws_size < WS_END) {
            fprintf(stderr, "kernel_launch: unexpected shapes (n_in %d, in0 %d, out %d, ws %zu, need %zu); nothing launched\n", n_in, n_in > 0 ? in_sizes[0] : -1, out_size, ws_size, (size_t)WS_END);
            grid = -1; return; }
        int dev = 0, cus = 0, per_cu = 0;
        if (hipGetDevice(&dev) != hipSuccess || hipDeviceGetAttribute(&cus, hipDeviceAttributeMultiprocessorCount, dev) != hipSuccess) { grid = -1; return; }
        if (hipFuncSetAttribute((const void*)fwd_megakernel, hipFuncAttributeMaxDynamicSharedMemorySize, LDS_BYTES) != hipSuccess) { fprintf(stderr, "kernel_launch: hipFuncSetAttribute failed\n"); grid = -1; return; }
        if (hipOccupancyMaxActiveBlocksPerMultiprocessor(&per_cu, (const void*)fwd_megakernel, 512, LDS_BYTES) != hipSuccess || per_cu < 1) { fprintf(stderr, "kernel_launch: occupancy query says %d blocks per CU\n", per_cu); per_cu = 1; }
        (void)hipGetLastError();
        grid = cus;
    }
    if (grid < 0) return;
    Args a{};
    a.x = (const float*)d_in[0]; a.p = (const float*)d_in[1]; a.pool_w = (const float*)d_in[2]; a.pool_scale = (const float*)d_in[3]; a.ssm_in_w = (const float*)d_in[4];
    a.conv_w = (const float*)d_in[5]; a.conv_b = (const float*)d_in[6]; a.dt_bias = (const float*)d_in[7]; a.a_log = (const float*)d_in[8]; a.d_skip = (const float*)d_in[9];
    a.norm_w = (const float*)d_in[10]; a.out_w = (const float*)d_in[11]; a.w1 = (const float*)d_in[12]; a.w2 = (const float*)d_in[13]; a.ln_g = (const float*)d_in[14];
    a.ln_b = (const float*)d_in[15]; a.ple_w = (const float*)d_in[16]; a.gate_w = (const float*)d_in[17];
    a.out = (float*)d_out; a.ws = (unsigned char*)d_ws;
    void* args[] = {&a};
    const hipError_t e = hipLaunchCooperativeKernel((const void*)fwd_megakernel, dim3(grid), dim3(512), args, LDS_BYTES, stream);
    if (e != hipSuccess) fprintf(stderr, "kernel_launch: cooperative launch failed: %s (grid %d)\n", hipGetErrorString(e), grid);
}
```

```cpp
#include <hip/hip_runtime.h>
#include <hip/hip_cooperative_groups.h>
#include <cstdio>
#include <cstdint>
namespace cg = cooperative_groups;

#define LAS __attribute__((address_space(3)))
typedef unsigned short bf16_t;
typedef short bf16x8 __attribute__((ext_vector_type(8)));
typedef float f32x4 __attribute__((ext_vector_type(4)));
typedef float f32x2 __attribute__((ext_vector_type(2)));
typedef unsigned u32x4 __attribute__((ext_vector_type(4)));
typedef unsigned u32x2 __attribute__((ext_vector_type(2)));

constexpr int MROWS = 16384, DM = 2048, DFF = 8192, DIN = 4096, ZXW = 10240, NINP = 10496, NIN = 10304, SEQL = 2048, NB = 8, PLED = 256;
constexpr int NHEAD = 64, HDIM = 64, NGRP = 8, DSTATE = 128, CONVD = 6144, CHUNKL = 128, NCHUNK = 16;
constexpr float ALPHA_F = 1.41421356237309515f;
constexpr float LN_EPS_F = 1e-5f, RMS_EPS_F = 1e-5f;

constexpr size_t MiB = 1024 * 1024;
constexpr size_t WS_SSQ = 0;
constexpr size_t WS_BAR = 131072;
constexpr size_t WS_ST1 = 262144, WS_ST2 = 393216;
constexpr size_t WS_UV = 524288;
constexpr int UV_LAYER = 20480, UV_U1 = 0, UV_V1 = 8192, UV_UG = 16384, UV_VG = 18432;
constexpr size_t WS_W = 1 * MiB;
constexpr size_t W_W1 = 0, W_W2 = 33554432, W_GATE = 67108864, W_PLE = 75497472, W_A = 76546048, W_OUT = 119537664, W_END = 136314880;
constexpr size_t WS_XB = WS_W + W_END;
constexpr size_t WS_PBF = WS_XB + 67108864;
constexpr size_t WS_DT = WS_PBF + 16777216;
constexpr size_t WS_BIG = WS_DT + 4194304;
constexpr size_t BIG_PW = 268435456;
constexpr size_t WS_HALO = WS_BIG + 335544320;
constexpr size_t WS_END = WS_HALO + (size_t)128 * 3 * 6144 * 2;

constexpr int LDS_BYTES = 163840, L_BARST = 163824;

typedef __bf16 bf16x2_t __attribute__((ext_vector_type(2)));
__device__ __forceinline__ unsigned cvt_pk_bf16(float lo, float hi) { const f32x2 v = {lo, hi}; const bf16x2_t b = __builtin_convertvector(v, bf16x2_t); unsigned r; __builtin_memcpy(&r, &b, 4); return r; }
__device__ __forceinline__ float bf_lo(unsigned w) { return __uint_as_float(w << 16); }
__device__ __forceinline__ float bf_hi(unsigned w) { return __uint_as_float(w & 0xffff0000u); }
__device__ __forceinline__ float wave_sum(float v) {
#pragma unroll
    for (int o = 1; o < 64; o <<= 1) v += __shfl_xor(v, o);
    return v;
}
__device__ __forceinline__ float rdlane(float v, int l) { return __int_as_float(__builtin_amdgcn_readlane(__float_as_int(v), l)); }
__device__ __forceinline__ float fast_sigmoid(float v) { return __builtin_amdgcn_rcpf(1.0f + __expf(-v)); }
__device__ __forceinline__ float fast_silu(float v) { return v * fast_sigmoid(v); }
#define LDS_WAIT() asm volatile("s_waitcnt lgkmcnt(0)" ::: "memory")
__device__ __forceinline__ int launder_s(int v) { asm volatile("" : "+s"(v)); return v; }
__device__ __forceinline__ int launder(int v) { asm volatile("" : "+v"(v)); return v; }


#define XB_TMO      128
#define XB_XCNT(j)  (256  + 64 * (j))
#define XB_XSUB(j)  (1280 + 64 * (j))
#define XB_XGEN(j)  (2304 + 64 * (j))
#define XB_TOP      3328
#define XB_TOPGEN   3392
#define XCD_BAR_WORDS 3456
#define XB_SPIN_CAP (1u << 20)
__device__ __forceinline__ unsigned xb_ld(unsigned* p)              { return __hip_atomic_load(p, __ATOMIC_RELAXED, __HIP_MEMORY_SCOPE_AGENT); }
__device__ __forceinline__ unsigned xb_add(unsigned* p, unsigned v) { return __hip_atomic_fetch_add(p, v, __ATOMIC_RELAXED, __HIP_MEMORY_SCOPE_AGENT); }
__device__ __forceinline__ unsigned xb_xcc_id() { return (unsigned)__builtin_amdgcn_s_getreg((3 << 11) | 20) & 0xFu; }
#define XB_SPIN(cond, bar) do { unsigned _sp = 0; while (cond) { __builtin_amdgcn_s_sleep(1); \
    if ((++_sp & 255u) == 0u) { if (xb_ld(&(bar)[XB_TMO])) break; if (_sp > XB_SPIN_CAP) { atomicAdd(&(bar)[XB_TMO], 1u); break; } } } } while (0)
__device__ __forceinline__ void xcd_barrier_post(unsigned* bar) { if (threadIdx.x == 0) (void)xb_add(&bar[XB_XCNT(xb_xcc_id())], 1u); }
__device__ __forceinline__ void xcd_barrier_complete(unsigned* bar, unsigned x, unsigned& nloc, unsigned& nx) {
    const unsigned G = gridDim.x;
    unsigned sum, cnt, mine, sp = 0u;
    for (;;) {
        sum = 0u; cnt = 0u; mine = 0u;
#pragma unroll
        for (unsigned j = 0; j < 16; ++j) { const unsigned c = xb_ld(&bar[XB_XCNT(j)]); sum += c; cnt += (c > 0u) ? 1u : 0u; mine = (j == x) ? c : mine; }
        if (sum == G) break;
        __builtin_amdgcn_s_sleep(1);
        if ((++sp & 255u) == 0u) { if (xb_ld(&bar[XB_TMO])) break; if (sp > XB_SPIN_CAP) { atomicAdd(&bar[XB_TMO], 1u); break; } }
    }
    nloc = mine > 0u ? mine : 1u; nx = cnt > 0u ? cnt : 1u;
}
__device__ __forceinline__ void xcd_barrier(unsigned* bar, volatile LAS unsigned* st) {
    asm volatile("s_waitcnt vmcnt(0)" ::: "memory");
    __syncthreads();
    if (threadIdx.x == 0) {
        __builtin_amdgcn_s_waitcnt(0);
        const unsigned x = xb_xcc_id();
        unsigned nloc = st[0], nx = st[1];
        if (nloc == 0u) { xcd_barrier_complete(bar, x, nloc, nx); st[0] = nloc; st[1] = nx; }
        const unsigned old = xb_add(&bar[XB_XSUB(x)], 1u);
        const unsigned gen = old / nloc;
        if (old + 1u == (gen + 1u) * nloc) {
            __builtin_amdgcn_fence(__ATOMIC_RELEASE, "agent");
            asm volatile("s_waitcnt vmcnt(0)" ::: "memory");
            const unsigned og = xb_add(&bar[XB_TOP], 1u);
            const unsigned tg = og / nx;
            if (og + 1u == (tg + 1u) * nx) xb_add(&bar[XB_TOPGEN], 1u);
            else XB_SPIN(xb_ld(&bar[XB_TOPGEN]) == tg, bar);
            __builtin_amdgcn_fence(__ATOMIC_ACQUIRE, "agent");
            xb_add(&bar[XB_XGEN(x)], 1u);
            asm volatile("s_waitcnt vmcnt(0)" ::: "memory");
        } else {
            XB_SPIN(xb_ld(&bar[XB_XGEN(x)]) == gen, bar);
            __builtin_amdgcn_fence(__ATOMIC_ACQUIRE, "agent");
            asm volatile("s_waitcnt vmcnt(0)" ::: "memory");
        }
    }
    __syncthreads();
}

namespace pg8 {
constexpr int BM = 256, BK = 64, HALF = 128, HTB = HALF * BK * 2, STAGE_BYTES = 8 * HTB, NXCD = 8, WGM = 8;
__host__ __device__ __forceinline__ int lds_byte(int r, int c) { const int st = (r >> 4) * 2 + (c >> 5), rr = r & 15, cc = c & 31, ob = rr * 64 + cc * 2; return st * 1024 + (ob ^ (((ob >> 9) & 1) << 5)); }
__host__ __device__ __forceinline__ void stage_rc(int b, int& R, int& C) { const int st = b / 1024, sb = b % 1024, swz = sb ^ (((sb >> 9) & 1) << 5); R = (st >> 1) * 16 + swz / 64; C = (st & 1) * 32 + (swz % 64) / 2; }
__host__ __device__ __forceinline__ int perm32(int rho) { const int n = rho >> 4, i = rho & 15; return 8 * (i >> 2) + 4 * n + (i & 3); }

struct Unit { int pm, pn; };
struct Gemm { const bf16_t* A; const bf16_t* Bt; int lda, ldb, K, tpg, goff; };

struct StaticOrder {
    int nM, nN, nwg, G, c, pm0;
    __device__ void init(int M, int N, int G_, int c_, int pm0_ = 0) { nM = M / BM; nN = N / BM; nwg = nM * nN; G = G_; c = c_; pm0 = pm0_; }
    __device__ bool next(int i, Unit& u) const {
        const long L = (long)i * G + c; if (L >= nwg) return false;
        int wgid = (int)L; { const int q = nwg / NXCD, r = nwg % NXCD, xcd = wgid % NXCD, off = wgid / NXCD; wgid = (xcd < r ? xcd * (q + 1) : r * (q + 1) + (xcd - r) * q) + off; }
        const int nig = WGM * nN, gid = wgid / nig, fm = gid * WGM, gsz = (nM - fm) < WGM ? (nM - fm) : WGM;
        u.pm = pm0 + fm + ((wgid % nig) % gsz); u.pn = (wgid % nig) / gsz; return true;
    }
};

template <int ACT  > struct EpiBf16 {
    static constexpr bool PERM = true;
    bf16_t* O; int ldc;
    __device__ __forceinline__ void operator()(const f32x4 (&acc)[2][2][4][2], const Unit& u, int wr, int wc, int fr, int fq) const {
        const int row0 = u.pm * BM + wr * 64 + fr, col0 = u.pn * BM + wc * 32 + 8 * fq;
#pragma unroll
        for (int ai = 0; ai < 2; ++ai)
#pragma unroll
            for (int m = 0; m < 4; ++m) { bf16_t* rowp = O + (size_t)(row0 + ai * HALF + m * 16) * ldc + col0;
#pragma unroll
                for (int bj = 0; bj < 2; ++bj) { f32x4 v0 = acc[ai][bj][m][0], v1 = acc[ai][bj][m][1];
                    if (ACT == 1) {
#pragma unroll
                        for (int j = 0; j < 4; ++j) { const float a = fmaxf(v0[j], 0.f), b = fmaxf(v1[j], 0.f); v0[j] = a * a; v1[j] = b * b; }
                        asm volatile("" : "+v"(v0), "+v"(v1)); }
                    u32x4 w; w.x = cvt_pk_bf16(v0[0], v0[1]); w.y = cvt_pk_bf16(v0[2], v0[3]); w.z = cvt_pk_bf16(v1[0], v1[1]); w.w = cvt_pk_bf16(v1[2], v1[3]);
                    *(u32x4*)(rowp + bj * HALF) = w; }
                asm volatile("" ::: "memory"); }
    }
};
struct EpiInProj {
    static constexpr bool PERM = true;
    bf16_t* O; float* DT; const float* dt_bias; bf16_t* HALO;
    __device__ __forceinline__ void operator()(const f32x4 (&acc)[2][2][4][2], const Unit& u, int wr, int wc, int fr, int fq) const {
        const int row0 = u.pm * BM + wr * 64 + fr;
        if (u.pn < 40) {
            const int col0 = u.pn * BM + wc * 32 + 8 * fq;
            const bool halo_lane = (u.pn >= 16) && (wr == 1) && (fr >= 13);
#pragma unroll
            for (int ai = 0; ai < 2; ++ai)
#pragma unroll
                for (int m = 0; m < 4; ++m) { const int row = row0 + ai * HALF + m * 16; bf16_t* rowp = O + (size_t)row * ZXW + col0;
#pragma unroll
                    for (int bj = 0; bj < 2; ++bj) { const f32x4 v0 = acc[ai][bj][m][0], v1 = acc[ai][bj][m][1];
                        u32x4 w; w.x = cvt_pk_bf16(v0[0], v0[1]); w.y = cvt_pk_bf16(v0[2], v0[3]); w.z = cvt_pk_bf16(v1[0], v1[1]); w.w = cvt_pk_bf16(v1[2], v1[3]);
                        *(u32x4*)(rowp + bj * HALF) = w;
                        if (m == 3 && halo_lane) *(u32x4*)(HALO + ((size_t)(row >> 7) * 3 + (fr - 13)) * CONVD + (col0 + bj * HALF - DIN)) = w; } }
        } else if (wc < 2) {
            const int c0 = wc * 32 + 8 * fq;
            const f32x4 b0 = *(const f32x4*)(dt_bias + c0), b1 = *(const f32x4*)(dt_bias + c0 + 4);
#pragma unroll
            for (int ai = 0; ai < 2; ++ai)
#pragma unroll
                for (int m = 0; m < 4; ++m) { float* rowp = DT + (size_t)(row0 + ai * HALF + m * 16) * 64 + c0;
                    f32x4 v0 = acc[ai][0][m][0] + b0, v1 = acc[ai][0][m][1] + b1;
#pragma unroll
                    for (int j = 0; j < 4; ++j) { v0[j] = v0[j] > 20.f ? v0[j] : log1pf(__expf(v0[j])); v1[j] = v1[j] > 20.f ? v1[j] : log1pf(__expf(v1[j])); }
                    *(f32x4*)rowp = v0; *(f32x4*)(rowp + 4) = v1; }
        }
    }
};
__device__ __forceinline__ void ln_row_stats(const float* st, int row, float& mu, float& rstd) {
    const f32x2 sv = *(const f32x2*)(st + 2 * (size_t)row); mu = sv[0] * (1.0f / DM); const float var = sv[1] * (1.0f / DM) - mu * mu; rstd = __builtin_amdgcn_rsqf(fmaxf(var, 0.f) + LN_EPS_F);
}
template <int MODE> struct EpiRes {
    static constexpr bool PERM = true;
    float* XFp; bf16_t* XBo; const float* xin; const float* scale; const float* ssq; const bf16_t* PWp;
    const float* st_in; float* st_out; const float* lg; const float* lb; const float* uu; const float* vv;
    const bf16_t* XBi; int out_bf16;
    __device__ __forceinline__ void operator()(const f32x4 (&acc)[2][2][4][2], const Unit& u, int wr, int wc, int fr, int fq) const {
        const int row0 = u.pm * BM + wr * 64 + fr, col0 = u.pn * BM + wc * 32 + 8 * fq;
        float mu[8], rstd[8], s1[8], s2[8];
#pragma unroll
        for (int i = 0; i < 8; ++i) { const int row = row0 + (i >> 2) * HALF + (i & 3) * 16; mu[i] = 0.f; rstd[i] = 1.f; s1[i] = 0.f; s2[i] = 0.f;
            if (MODE == 1 || MODE == 3) ln_row_stats(st_in, row, mu[i], rstd[i]);
            if (MODE == 2) rstd[i] = __builtin_amdgcn_rsqf(ssq[row] * (1.0f / DIN) + RMS_EPS_F); }
#pragma unroll
        for (int bj = 0; bj < 2; ++bj) { const int cc = col0 + bj * HALF;
            f32x4 g0, g1, b0, b1, u0, u1, v0, v1;
            if (MODE == 0) { g0 = *(const f32x4*)(scale + cc); g1 = *(const f32x4*)(scale + cc + 4); }
            if (MODE == 1 || MODE == 3) { g0 = *(const f32x4*)(lg + cc); g1 = *(const f32x4*)(lg + cc + 4); b0 = *(const f32x4*)(lb + cc); b1 = *(const f32x4*)(lb + cc + 4); }
            if (MODE == 3) { u0 = *(const f32x4*)(uu + cc); u1 = *(const f32x4*)(uu + cc + 4); v0 = *(const f32x4*)(vv + cc); v1 = *(const f32x4*)(vv + cc + 4); }
#pragma unroll
            for (int i = 0; i < 8; ++i) { const int ai = i >> 2, m = i & 3; const size_t o = (size_t)(row0 + ai * HALF + m * 16) * DM + cc;
                const f32x4 a0 = acc[ai][bj][m][0], a1 = acc[ai][bj][m][1]; f32x4 r0, r1, t0, t1;
                if (MODE == 0) { t0 = *(const f32x4*)(xin + o); t1 = *(const f32x4*)(xin + o + 4); r0 = t0 * ALPHA_F + a0 * g0; r1 = t1 * ALPHA_F + a1 * g1; }
                if (MODE != 0) { const u32x4 tw = *(const u32x4*)(XBi + o);
                    t0 = (f32x4){bf_lo(tw.x), bf_hi(tw.x), bf_lo(tw.y), bf_hi(tw.y)}; t1 = (f32x4){bf_lo(tw.z), bf_hi(tw.z), bf_lo(tw.w), bf_hi(tw.w)}; }
                if (MODE == 1) { r0 = ((t0 - mu[i]) * rstd[i] * g0 + b0) * ALPHA_F + a0; r1 = ((t1 - mu[i]) * rstd[i] * g1 + b1) * ALPHA_F + a1; }
                if (MODE == 2) { r0 = t0 * ALPHA_F + a0 * rstd[i]; r1 = t1 * ALPHA_F + a1 * rstd[i]; }
                if (MODE == 3) { const u32x4 pw = *(const u32x4*)(PWp + o);
                    const f32x4 x0 = (t0 - mu[i]) * rstd[i] * g0 + b0, x1 = (t1 - mu[i]) * rstd[i] * g1 + b1;
                    const f32x4 p0 = (a0 - u0 * mu[i]) * rstd[i] + v0, p1 = (a1 - u1 * mu[i]) * rstd[i] + v1;
                    r0[0] = x0[0] + fast_sigmoid(p0[0]) * bf_lo(pw.x); r0[1] = x0[1] + fast_sigmoid(p0[1]) * bf_hi(pw.x); r0[2] = x0[2] + fast_sigmoid(p0[2]) * bf_lo(pw.y); r0[3] = x0[3] + fast_sigmoid(p0[3]) * bf_hi(pw.y);
                    r1[0] = x1[0] + fast_sigmoid(p1[0]) * bf_lo(pw.z); r1[1] = x1[1] + fast_sigmoid(p1[1]) * bf_hi(pw.z); r1[2] = x1[2] + fast_sigmoid(p1[2]) * bf_lo(pw.w); r1[3] = x1[3] + fast_sigmoid(p1[3]) * bf_hi(pw.w);
                    if (out_bf16) { u32x4 w; w.x = cvt_pk_bf16(r0[0], r0[1]); w.y = cvt_pk_bf16(r0[2], r0[3]); w.z = cvt_pk_bf16(r1[0], r1[1]); w.w = cvt_pk_bf16(r1[2], r1[3]); *(u32x4*)(XBo + o) = w; }
                    else { *(f32x4*)(XFp + o) = r0; *(f32x4*)(XFp + o + 4) = r1; } }
                if (MODE != 3) { u32x4 w; w.x = cvt_pk_bf16(r0[0], r0[1]); w.y = cvt_pk_bf16(r0[2], r0[3]); w.z = cvt_pk_bf16(r1[0], r1[1]); w.w = cvt_pk_bf16(r1[2], r1[3]);
                    *(u32x4*)(XBo + o) = w;
                    const float q0 = bf_lo(w.x), q1 = bf_hi(w.x), q2 = bf_lo(w.y), q3 = bf_hi(w.y), q4 = bf_lo(w.z), q5 = bf_hi(w.z), q6 = bf_lo(w.w), q7 = bf_hi(w.w);
                    s1[i] += ((q0 + q1) + (q2 + q3)) + ((q4 + q5) + (q6 + q7)); s2[i] += ((q0 * q0 + q1 * q1) + (q2 * q2 + q3 * q3)) + ((q4 * q4 + q5 * q5) + (q6 * q6 + q7 * q7)); } }
            asm volatile("" ::: "memory"); }
        if (MODE != 3) {
#pragma unroll
            for (int i = 0; i < 8; ++i) { float a1 = s1[i], a2 = s2[i]; a1 += __shfl_xor(a1, 16); a1 += __shfl_xor(a1, 32); a2 += __shfl_xor(a2, 16); a2 += __shfl_xor(a2, 32);
                const int row = row0 + (i >> 2) * HALF + (i & 3) * 16;
                if (fq < 2) atomicAdd(st_out + 2 * (size_t)row + fq, fq == 0 ? a1 : a2); }
        }
    }
};
struct EpiUp {
    static constexpr bool PERM = true;
    bf16_t* O; const float* st_in; const float* uu; const float* vv;
    __device__ __forceinline__ void operator()(const f32x4 (&acc)[2][2][4][2], const Unit& u, int wr, int wc, int fr, int fq) const {
        const int row0 = u.pm * BM + wr * 64 + fr, col0 = u.pn * BM + wc * 32 + 8 * fq;
        float mu[8], rstd[8];
#pragma unroll
        for (int i = 0; i < 8; ++i) ln_row_stats(st_in, row0 + (i >> 2) * HALF + (i & 3) * 16, mu[i], rstd[i]);
#pragma unroll
        for (int bj = 0; bj < 2; ++bj) { const int cc = col0 + bj * HALF;
            const f32x4 u0 = *(const f32x4*)(uu + cc), u1 = *(const f32x4*)(uu + cc + 4), w0 = *(const f32x4*)(vv + cc), w1 = *(const f32x4*)(vv + cc + 4);
#pragma unroll
            for (int i = 0; i < 8; ++i) { const int ai = i >> 2, m = i & 3;
                const float mr = mu[i] * rstd[i];
                f32x4 v0 = acc[ai][bj][m][0] * rstd[i] + (w0 - u0 * mr), v1 = acc[ai][bj][m][1] * rstd[i] + (w1 - u1 * mr);
#pragma unroll
                for (int j = 0; j < 4; ++j) { const float a = fmaxf(v0[j], 0.f), b = fmaxf(v1[j], 0.f); v0[j] = a * a; v1[j] = b * b; }
                u32x4 w; w.x = cvt_pk_bf16(v0[0], v0[1]); w.y = cvt_pk_bf16(v0[2], v0[3]); w.z = cvt_pk_bf16(v1[0], v1[1]); w.w = cvt_pk_bf16(v1[2], v1[3]);
                *(u32x4*)(O + (size_t)(row0 + ai * HALF + m * 16) * DFF + cc) = w; }
            asm volatile("" ::: "memory"); }
    }
};

template <class Epi>
__device__ __forceinline__ void gemm_phase(LAS unsigned char* lds, const Gemm g, const StaticOrder& S, const Epi& E) {
    const int tid = launder((int)threadIdx.x), wid = __builtin_amdgcn_readfirstlane(tid >> 6), lane = tid & 63, wr = wid >> 2, wc = wid & 3, fr = lane & 15, fq = lane >> 4;
    int nt = g.K / BK; asm volatile("" : "+s"(nt));
    unsigned voffA[2], voffB[2];
#pragma unroll
    for (int i = 0; i < 2; ++i) { int R, C; stage_rc(tid * 16 + i * 8192, R, C); const int Rb = Epi::PERM ? ((R & ~31) + perm32(R & 31)) : R;
        voffA[i] = (unsigned)(R * g.lda + C) * 2u; voffB[i] = (unsigned)(Rb * g.ldb + C) * 2u; }
    const size_t kstep = (size_t)(BK * 2);
    const size_t hstepA = (size_t)HALF * g.lda * 2, hstepB = (size_t)HALF * g.ldb * 2;
    const unsigned ldsw = (unsigned)wid * 1024u;
    const int aoff = lds_byte(wr * 64 + fr, fq * 8), boff = lds_byte(wc * 32 + fr, fq * 8);
#define PG8_APTR(u) ((const char*)g.A + (size_t)(u).pm * 2 * hstepA + (size_t)((u).pn / g.tpg) * (size_t)g.goff * 2)
#define PG8_BPTR(u) ((const char*)g.Bt + (size_t)(u).pn * 2 * hstepB)
#define PG8_SA(b, h) (((b) * 2 + (h)) * HTB)
#define PG8_SB(b, h) ((4 + (b) * 2 + (h)) * HTB)
#define PG8_STAGE(bufoff, gbase, voff) do { _Pragma("unroll") for (int _i = 0; _i < 2; ++_i) \
        __builtin_amdgcn_global_load_lds((const unsigned*)((const char*)(gbase) + (voff)[_i]), (LAS unsigned*)(lds + (bufoff) + ldsw + _i * 8192), 16, 0, 0); } while (0)
#define PG8_LDA(dst, b, h) do { _Pragma("unroll") for (int m = 0; m < 4; ++m) _Pragma("unroll") for (int k = 0; k < 2; ++k) dst[m][k] = *(const LAS bf16x8*)(lds + PG8_SA(b, h) + aoff + m * 2048 + k * 1024); } while (0)
#define PG8_LDB(dst, b, h) do { _Pragma("unroll") for (int n = 0; n < 2; ++n) _Pragma("unroll") for (int k = 0; k < 2; ++k) dst[n][k] = *(const LAS bf16x8*)(lds + PG8_SB(b, h) + boff + n * 2048 + k * 1024); } while (0)
#define PG8_MMA(ai, bj, At, Bt) do { __builtin_amdgcn_s_setprio(1); _Pragma("unroll") for (int m = 0; m < 4; ++m) _Pragma("unroll") for (int n = 0; n < 2; ++n) _Pragma("unroll") for (int k = 0; k < 2; ++k) \
        acc[ai][bj][m][n] = __builtin_amdgcn_mfma_f32_16x16x32_bf16(Bt[n][k], At[m][k], acc[ai][bj][m][n], 0, 0, 0); __builtin_amdgcn_s_setprio(0); } while (0)
#define PG8_WAIT_V(n) asm volatile("s_waitcnt vmcnt(" #n ")" ::: "memory")
#define PG8_WAIT_L(n) asm volatile("s_waitcnt lgkmcnt(" #n ")" ::: "memory")
#define PG8_BAR __builtin_amdgcn_s_barrier()
#define PG8_SCHED __builtin_amdgcn_sched_barrier(0)
    Unit cur, nxt; int ui = 0;
    if (!S.next(0, cur)) return;
    f32x4 acc[2][2][4][2];
#pragma unroll
    for (int a = 0; a < 2; ++a)
#pragma unroll
        for (int b = 0; b < 2; ++b)
#pragma unroll
            for (int m = 0; m < 4; ++m)
#pragma unroll
                for (int n = 0; n < 2; ++n) acc[a][b][m][n] = (f32x4){0.f, 0.f, 0.f, 0.f};
    bf16x8 At[4][2], B0[2][2], B1[2][2];
    const char* cA = PG8_APTR(cur); const char* cB = PG8_BPTR(cur);
    PG8_STAGE(PG8_SB(0, 0), cB, voffB); PG8_STAGE(PG8_SB(0, 1), cB + hstepB, voffB); PG8_STAGE(PG8_SA(0, 0), cA, voffA); PG8_STAGE(PG8_SA(0, 1), cA + hstepA, voffA);
    if (wr == 1) PG8_BAR;
    PG8_WAIT_V(2); PG8_BAR;
    PG8_STAGE(PG8_SB(1, 0), cB + kstep, voffB); PG8_STAGE(PG8_SA(1, 0), cA + kstep, voffA); PG8_STAGE(PG8_SB(1, 1), cB + hstepB + kstep, voffB);
    PG8_WAIT_V(6); PG8_BAR;
    for (;;) {
        const bool has_next = S.next(ui + 1, nxt);
        const char* nA = has_next ? PG8_APTR(nxt) : cA; const char* nB = has_next ? PG8_BPTR(nxt) : cB;
        for (int t = 0; t < nt; t += 2) {
            const bool last = (t == nt - 2);
            const char* a1 = cA + (size_t)(t + 1) * kstep;
            const char* a2 = last ? nA : cA + (size_t)(t + 2) * kstep; const char* b2 = last ? nB : cB + (size_t)(t + 2) * kstep;
            const char* a3 = a2 + kstep; const char* b3 = b2 + kstep;
            PG8_LDB(B0, 0, 0); PG8_LDB(B1, 0, 1); PG8_SCHED; PG8_LDA(At, 0, 0); PG8_STAGE(PG8_SA(1, 1), a1 + hstepA, voffA);
            PG8_WAIT_V(8); PG8_WAIT_L(0); PG8_BAR; PG8_MMA(0, 0, At, B0); PG8_MMA(0, 1, At, B1); PG8_BAR; PG8_SCHED;
            PG8_LDA(At, 0, 1); PG8_STAGE(PG8_SB(0, 0), b2, voffB); PG8_STAGE(PG8_SB(0, 1), b2 + hstepB, voffB); PG8_STAGE(PG8_SA(0, 0), a2, voffA);
            PG8_WAIT_V(8); PG8_WAIT_L(0); PG8_BAR; PG8_MMA(1, 0, At, B0); PG8_MMA(1, 1, At, B1); PG8_BAR; PG8_SCHED;
            PG8_LDB(B0, 1, 0); PG8_LDB(B1, 1, 1); PG8_SCHED; PG8_LDA(At, 1, 0); PG8_STAGE(PG8_SA(0, 1), a2 + hstepA, voffA);
            PG8_WAIT_V(8); PG8_WAIT_L(0); PG8_BAR; PG8_MMA(0, 0, At, B0); PG8_MMA(0, 1, At, B1); PG8_BAR; PG8_SCHED;
            PG8_LDA(At, 1, 1); PG8_STAGE(PG8_SB(1, 0), b3, voffB); PG8_STAGE(PG8_SB(1, 1), b3 + hstepB, voffB); PG8_STAGE(PG8_SA(1, 0), a3, voffA);
            PG8_WAIT_V(8); PG8_WAIT_L(0); PG8_BAR; PG8_MMA(1, 0, At, B0); PG8_MMA(1, 1, At, B1); PG8_BAR; PG8_SCHED;
        }
        if (wr == 0) PG8_BAR;
        asm volatile("s_nop 15\n\ts_nop 15" ::: "memory");
        E(acc, cur, wr, wc, fr, fq);
        if (!has_next) break;
#pragma unroll
        for (int a = 0; a < 2; ++a)
#pragma unroll
            for (int b = 0; b < 2; ++b)
#pragma unroll
                for (int m = 0; m < 4; ++m)
#pragma unroll
                    for (int n = 0; n < 2; ++n) acc[a][b][m][n] = (f32x4){0.f, 0.f, 0.f, 0.f};
        cur = nxt; cA = nA; cB = nB; ++ui;
        if (wr == 1) PG8_BAR;
    }
    PG8_WAIT_V(0);
    PG8_BAR;
#undef PG8_APTR
#undef PG8_BPTR
#undef PG8_SA
#undef PG8_SB
#undef PG8_STAGE
#undef PG8_LDA
#undef PG8_LDB
#undef PG8_MMA
#undef PG8_WAIT_V
#undef PG8_WAIT_L
#undef PG8_BAR
#undef PG8_SCHED
}
}

struct Args {
    const float* x; const float* p; const float* pool_w; const float* pool_scale; const float* ssm_in_w; const float* conv_w; const float* conv_b;
    const float* dt_bias; const float* a_log; const float* d_skip; const float* norm_w; const float* out_w; const float* w1; const float* w2;
    const float* ln_g; const float* ln_b; const float* ple_w; const float* gate_w;
    float* out; unsigned char* ws;
};

typedef __attribute__((address_space(4))) const Args CArgs;
__device__ __forceinline__ CArgs* kargs() { CArgs* p = (CArgs*)__builtin_amdgcn_kernarg_segment_ptr(); asm volatile("" : "+s"(p)); return p; }
#define KA(f) (kargs()->f)

__device__ __forceinline__ void transpose_item(const float* __restrict__ W, int K, int N, bf16_t* __restrict__ WT, int row_off, LAS float* scr, int item, int lane,
                                               const float* __restrict__ gk, const float* __restrict__ bk, float* uo, float* vo) {
    const int nblk = N / 32, kb = item / nblk, nb = item % nblk, k0 = 64 * kb, n0 = 32 * nb, hi = lane >> 5;
    const float* src = W + (size_t)(k0 + hi) * N + n0 + (lane & 31);
    float w[32];
#pragma unroll
    for (int i = 0; i < 32; ++i) w[i] = __builtin_nontemporal_load(src + (size_t)(2 * i) * N);
    if (gk) {
        const float gl = gk[k0 + lane], bl = bk ? bk[k0 + lane] : 0.f; float pu = 0.f, pv = 0.f;
#pragma unroll
        for (int i = 0; i < 32; ++i) { const float g0 = rdlane(gl, 2 * i), g1 = rdlane(gl, 2 * i + 1), b0 = rdlane(bl, 2 * i), b1 = rdlane(bl, 2 * i + 1);
            pv += w[i] * (hi ? b1 : b0); w[i] *= (hi ? g1 : g0); pu += bf_lo(cvt_pk_bf16(w[i], 0.f)); }
        if (uo) { pu += __shfl_xor(pu, 32); pv += __shfl_xor(pv, 32);
            atomicAdd((lane < 32 ? uo : vo) + n0 + (lane & 31), lane < 32 ? pu : pv); }
    }
#pragma unroll
    for (int i = 0; i < 32; ++i) scr[(2 * i + hi) * 33 + (lane & 31)] = w[i];
    LDS_WAIT();
    const int c = lane & 7;
#pragma unroll
    for (int j = 0; j < 4; ++j) { const int n = (lane >> 3) + 8 * j; const LAS float* sp = scr + (8 * c) * 33 + n;
        u32x4 o; o.x = cvt_pk_bf16(sp[0 * 33], sp[1 * 33]); o.y = cvt_pk_bf16(sp[2 * 33], sp[3 * 33]); o.z = cvt_pk_bf16(sp[4 * 33], sp[5 * 33]); o.w = cvt_pk_bf16(sp[6 * 33], sp[7 * 33]);
        *(u32x4*)(WT + (size_t)(row_off + n0 + n) * K + k0 + 8 * c) = o; }
    LDS_WAIT();
}
__device__ __forceinline__ void transpose_matrix(const float* W, int K, int N, bf16_t* WT, int row_off, LAS float* scr, int gw, int ngw, int lane,
                                                 const float* gk = nullptr, const float* bk = nullptr, float* uo = nullptr, float* vo = nullptr) {
    const int nitems = (K / 64) * (N / 32);
    for (int it = gw; it < nitems; it += ngw) transpose_item(W, K, N, WT, row_off, scr, it, lane, gk, bk, uo, vo);
}
__device__ __forceinline__ void cvt_rows(const float* src, bf16_t* dst, size_t n4, size_t gt, size_t ngt) {
    for (size_t i = gt; i < n4; i += ngt) { const f32x4 v = ((const f32x4*)src)[i]; u32x2 w; w.x = cvt_pk_bf16(v[0], v[1]); w.y = cvt_pk_bf16(v[2], v[3]); ((u32x2*)dst)[i] = w; }
}
template <int WIN> __device__ __forceinline__ void pool_item(const f32x4* __restrict__ xp, u32x2* __restrict__ op, int t0) {
    constexpr int NR = WIN - 1 + 16;
    f32x4 a[NR], orig[16];
#pragma unroll
    for (int i = 0; i < NR; ++i) { const int t = t0 - (WIN - 1) + i; a[i] = (t >= 0) ? xp[(size_t)t * 512] : (f32x4){0.f, 0.f, 0.f, 0.f}; }
#pragma unroll
    for (int r = 0; r < 16; ++r) orig[r] = a[WIN - 1 + r];
#pragma unroll
    for (int step = 1; step < WIN; step <<= 1)
#pragma unroll
        for (int i = NR - 1; i >= step; --i) a[i] += a[i - step];
#pragma unroll
    for (int r = 0; r < 16; ++r) { const int t = t0 + r; const float inv = 1.0f / (float)((t + 1) < WIN ? (t + 1) : WIN);
        const f32x4 o = a[WIN - 1 + r] * inv - orig[r];
        u32x2 w; w.x = cvt_pk_bf16(o[0], o[1]); w.y = cvt_pk_bf16(o[2], o[3]); op[(size_t)t * 512] = w; }
}
__device__ __forceinline__ void pool_phase(const float* x, bf16_t* PB, int gt, int ngt) {
    for (int it = gt; it < NB * 128 * 512; it += ngt) {
        const int c4 = it & 511, seg = (it >> 9) & 127, b = it >> 16, gi = __builtin_amdgcn_readfirstlane(c4 >> 7);
        const f32x4* xp = (const f32x4*)(x + (size_t)b * SEQL * DM) + c4;
        u32x2* op = (u32x2*)(PB + (size_t)b * SEQL * DM) + c4;
        if (gi == 0) pool_item<2>(xp, op, seg * 16); else if (gi == 1) pool_item<4>(xp, op, seg * 16); else if (gi == 2) pool_item<8>(xp, op, seg * 16); else pool_item<16>(xp, op, seg * 16);
    }
}

__device__ __forceinline__ void dt_phase(const bf16_t* X, const bf16_t* WT, const float* dt_bias, float* DTo, int row_lo, int ntask) {
    const int tid = launder((int)threadIdx.x), wid = __builtin_amdgcn_readfirstlane(tid >> 6), lane = tid & 63, fr = lane & 15, fq = lane >> 4;
    for (int task = blockIdx.x * 8 + wid; task < ntask; task += gridDim.x * 8) {
        const int r0 = row_lo + (task >> 1) * 16, n0 = (task & 1) * 32;
        const bf16_t* xa = X + (size_t)(r0 + fr) * DM + fq * 8;
        const bf16_t* wb = WT + (size_t)(ZXW + n0 + fr) * DM + fq * 8;
        f32x4 a0 = (f32x4){0.f, 0.f, 0.f, 0.f}, a1 = (f32x4){0.f, 0.f, 0.f, 0.f};
#pragma unroll 8
        for (int k = 0; k < DM; k += 32) {
            const bf16x8 xf = *(const bf16x8*)(xa + k), w0 = *(const bf16x8*)(wb + k), w1 = *(const bf16x8*)(wb + (size_t)16 * DM + k);
            a0 = __builtin_amdgcn_mfma_f32_16x16x32_bf16(w0, xf, a0, 0, 0, 0); a1 = __builtin_amdgcn_mfma_f32_16x16x32_bf16(w1, xf, a1, 0, 0, 0);
        }
        const f32x4 b0 = *(const f32x4*)(dt_bias + n0 + 4 * fq), b1 = *(const f32x4*)(dt_bias + n0 + 16 + 4 * fq);
        f32x4 v0 = a0 + b0, v1 = a1 + b1;
#pragma unroll
        for (int j = 0; j < 4; ++j) { v0[j] = v0[j] > 20.f ? v0[j] : log1pf(__expf(v0[j])); v1[j] = v1[j] > 20.f ? v1[j] : log1pf(__expf(v1[j])); }
        float* o = DTo + (size_t)(r0 + fr) * 64 + n0 + 4 * fq;
        *(f32x4*)o = v0; *(f32x4*)(o + 16) = v1;
    }
}

#define UNPK(dst, SRC_) do { dst[0] = bf_lo((SRC_).x); dst[1] = bf_hi((SRC_).x); dst[2] = bf_lo((SRC_).y); dst[3] = bf_hi((SRC_).y); dst[4] = bf_lo((SRC_).z); dst[5] = bf_hi((SRC_).z); dst[6] = bf_lo((SRC_).w); dst[7] = bf_hi((SRC_).w); } while (0)
__device__ __forceinline__ void conv_phase(bf16_t* zx, const bf16_t* HALO, const float* conv_w, const float* conv_b) {
    const int tid = launder((int)threadIdx.x), seg = tid >> 6, cgi = tid & 63;
    for (int item = blockIdx.x; item < 128 * 12; item += gridDim.x) {
        const int bc = item / 12, ch = (item % 12) * 512 + cgi * 8;
        bf16_t* base = zx + ((size_t)bc * CHUNKL + seg * 16) * ZXW + DIN + ch;
        u32x4 hal[3], raw[16];
#pragma unroll
        for (int r = 0; r < 3; ++r) {
            if (seg == 0) hal[r] = ((bc & 15) == 0) ? (u32x4){0u, 0u, 0u, 0u} : *(const u32x4*)(HALO + ((size_t)(bc - 1) * 3 + r) * CONVD + ch);
            else hal[r] = *(const u32x4*)(base + (ptrdiff_t)(r - 3) * ZXW);
        }
#pragma unroll
        for (int r = 0; r < 16; ++r) raw[r] = *(const u32x4*)(base + (size_t)r * ZXW);
        float cw[4][8], cb[8];
#pragma unroll
        for (int k = 0; k < 4; ++k) { const f32x4 w0 = *(const f32x4*)(conv_w + k * CONVD + ch), w1 = *(const f32x4*)(conv_w + k * CONVD + ch + 4);
#pragma unroll
            for (int i = 0; i < 4; ++i) { cw[k][i] = w0[i]; cw[k][4 + i] = w1[i]; } }
        { const f32x4 b0 = *(const f32x4*)(conv_b + ch), b1 = *(const f32x4*)(conv_b + ch + 4);
#pragma unroll
          for (int i = 0; i < 4; ++i) { cb[i] = b0[i]; cb[4 + i] = b1[i]; } }
        asm volatile("s_waitcnt vmcnt(0)" ::: "memory");
        __syncthreads();
        float u0[8], u1[8], u2[8];
        UNPK(u0, hal[0]); UNPK(u1, hal[1]); UNPK(u2, hal[2]);
#pragma unroll
        for (int r = 0; r < 16; ++r) {
            float cu[8], v[8]; UNPK(cu, raw[r]);
#pragma unroll
            for (int i = 0; i < 8; ++i) { const float a = cb[i] + cw[0][i] * u0[i] + cw[1][i] * u1[i] + cw[2][i] * u2[i] + cw[3][i] * cu[i]; v[i] = fast_silu(a); u0[i] = u1[i]; u1[i] = u2[i]; u2[i] = cu[i]; }
            u32x4 w; w.x = cvt_pk_bf16(v[0], v[1]); w.y = cvt_pk_bf16(v[2], v[3]); w.z = cvt_pk_bf16(v[4], v[5]); w.w = cvt_pk_bf16(v[6], v[7]);
            *(u32x4*)(base + (size_t)r * ZXW) = w;
        }
    }
}

constexpr int SST = 272;
constexpr int L_SC = 0, L_SB = 34816, L_SM = 69632, L_SXT = 104448, L_SST = 121856, L_SX = 139264, SXS = 144, L_ACS = 157696, L_SSD_END = 158208;
static_assert(L_SSD_END <= LDS_BYTES, "SSD LDS map");

__device__ __forceinline__ void ssd_phase(LAS unsigned char* lds, bf16_t* zx, const float* DTp, const float* a_log,
                                          const float* d_skip, const float* norm_w, float* ssq) {
    const int tid = launder((int)threadIdx.x), wid = __builtin_amdgcn_readfirstlane(tid >> 6), lane = tid & 63, fr = lane & 15, fq = lane >> 4;
    const int bx = blockIdx.x, xcd = bx & 7, slot = bx >> 3;
    LAS float* sAcs = (LAS float*)(lds + L_ACS);
    for (int round = 0; round < 2; ++round) {
        int b, h;
        if (gridDim.x == 256) { const int q = ((slot >> 3) + 4 * round) * 8 + xcd; b = q >> 3; h = (q & 7) * 8 + (slot & 7); }
        else { const int item = bx + round * (int)gridDim.x; if (item >= NB * NHEAD) break; b = item >> 6; h = item & 63; }
        const int g = h >> 3;
        const float a_h = -__expf(a_log[h]), d_h = d_skip[h];
        f32x4 st[4];
#pragma unroll
        for (int i = 0; i < 4; ++i) st[i] = (f32x4){0.f, 0.f, 0.f, 0.f};
        __syncthreads();
        for (int i = tid; i < 64 * SST / 4; i += 512) ((LAS unsigned*)(lds + L_SST))[i] = 0u;
        const bf16_t* xsrc = zx + ((size_t)b * SEQL) * ZXW + DIN;
        u32x4 pf[10]; float pdt[2], sdt[2];
#define SSD_PREFETCH(cc) do { \
        _Pragma("unroll") for (int i = 0; i < 2; ++i) { const int q = tid + 512 * i, l = q & 127, pc = q >> 7; \
            pf[i] = *(const u32x4*)(xsrc + (size_t)((cc) * CHUNKL + l) * ZXW + h * 64 + pc * 8); pdt[i] = DTp[((size_t)b * SEQL + (cc) * CHUNKL + l) * 64 + h]; } \
        _Pragma("unroll") for (int i = 2; i < 6; ++i) { const int q = tid + 512 * i - 1024, l = q >> 4, pc = q & 15; \
            pf[i] = *(const u32x4*)(xsrc + (size_t)((cc) * CHUNKL + l) * ZXW + DIN + g * 128 + pc * 8); } \
        _Pragma("unroll") for (int i = 6; i < 10; ++i) { const int q = tid + 512 * i - 3072, l = q >> 4, pc = q & 15; \
            pf[i] = *(const u32x4*)(xsrc + (size_t)((cc) * CHUNKL + l) * ZXW + DIN + NGRP * DSTATE + g * 128 + pc * 8); } \
        if (wid == 7) { const size_t r0 = (size_t)b * SEQL + (cc) * CHUNKL + 2 * lane; sdt[0] = DTp[r0 * 64 + h]; sdt[1] = DTp[(r0 + 1) * 64 + h]; } } while (0)
        SSD_PREFETCH(0);
        const int l0 = wid * 16, kbmax = wid >> 1;
        for (int c = 0; c < NCHUNK; ++c) {
            __syncthreads();
#pragma unroll
            for (int i = 0; i < 2; ++i) { const int q = tid + 512 * i, l = q & 127, pc = q >> 7;
                *(LAS u32x4*)(lds + L_SX + l * SXS + pc * 16) = pf[i];
                float v[8]; UNPK(v, pf[i]); const float d = pdt[i];
#pragma unroll
                for (int j = 0; j < 8; j += 2) { const unsigned pk = cvt_pk_bf16(v[j] * d, v[j + 1] * d);
                    *(LAS unsigned short*)(lds + L_SXT + (pc * 8 + j) * SST + l * 2) = (unsigned short)(pk & 0xffffu);
                    *(LAS unsigned short*)(lds + L_SXT + (pc * 8 + j + 1) * SST + l * 2) = (unsigned short)(pk >> 16); } }
#pragma unroll
            for (int i = 2; i < 6; ++i) { const int q = tid + 512 * i - 1024, l = q >> 4, pc = q & 15; *(LAS u32x4*)(lds + L_SB + l * SST + pc * 16) = pf[i]; }
#pragma unroll
            for (int i = 6; i < 10; ++i) { const int q = tid + 512 * i - 3072, l = q >> 4, pc = q & 15; *(LAS u32x4*)(lds + L_SC + l * SST + pc * 16) = pf[i]; }
            if (wid == 7) {
                const float da0 = sdt[0] * a_h, da1 = sdt[1] * a_h;
                float s = da0 + da1;
#pragma unroll
                for (int o = 1; o < 64; o <<= 1) { const float t = __shfl_up(s, o); if (lane >= o) s += t; }
                sAcs[2 * lane] = s - da1; sAcs[2 * lane + 1] = s;
            }
            __syncthreads();
            const int l = l0 + fr;
            const size_t row = (size_t)b * SEQL + c * CHUNKL + l;
            bf16_t* zp = zx + row * ZXW + h * 64 + 4 * fq;
            u32x2 zr[4];
#pragma unroll
            for (int pt = 0; pt < 4; ++pt) zr[pt] = *(const u32x2*)(zp + pt * 16);
            if (c + 1 < NCHUNK) SSD_PREFETCH(c + 1);
            const float acs_end = sAcs[CHUNKL - 1];
#pragma unroll
            for (int i = 0; i < 4; ++i) { const int item = tid + 512 * i, ll = item & 127, ng = item >> 7;
                const float dec = __expf(acs_end - sAcs[ll]);
                const u32x4 w = *(const LAS u32x4*)(lds + L_SB + ll * SST + ng * 16);
                float v[8]; UNPK(v, w);
#pragma unroll
                for (int j = 0; j < 8; j += 2) { const unsigned pk = cvt_pk_bf16(v[j] * dec, v[j + 1] * dec);
                    *(LAS unsigned short*)(lds + L_SM + (ng * 8 + j) * SST + ll * 2) = (unsigned short)(pk & 0xffffu);
                    *(LAS unsigned short*)(lds + L_SM + (ng * 8 + j + 1) * SST + ll * 2) = (unsigned short)(pk >> 16); } }
            {
                bf16x8 yc[4];
#pragma unroll
                for (int kb = 0; kb < 4; ++kb) yc[kb] = *(const LAS bf16x8*)(lds + L_SC + (l0 + fr) * SST + kb * 64 + fq * 16);
                const float acs_l = sAcs[l];
                f32x4 yd[4], yo[4];
#pragma unroll
                for (int i = 0; i < 4; ++i) { yd[i] = (f32x4){0.f, 0.f, 0.f, 0.f}; yo[i] = (f32x4){0.f, 0.f, 0.f, 0.f}; }
                for (int kp = 0; kp <= kbmax; ++kp) {
                    const int t0 = 2 * kp, t1 = 2 * kp + 1; const bool do1 = (t1 <= wid);
                    bf16x8 xb0[4], xb1[4]; u32x2 x0[4], x1[4];
#pragma unroll
                    for (int kb = 0; kb < 4; ++kb) { xb0[kb] = *(const LAS bf16x8*)(lds + L_SB + (t0 * 16 + fr) * SST + kb * 64 + fq * 16);
                        xb1[kb] = *(const LAS bf16x8*)(lds + L_SB + (t1 * 16 + fr) * SST + kb * 64 + fq * 16); }
                    const f32x4 as0 = *(const LAS f32x4*)(lds + L_ACS + (t0 * 16 + 4 * fq) * 4), as1 = *(const LAS f32x4*)(lds + L_ACS + (t1 * 16 + 4 * fq) * 4);
                    f32x4 a0 = (f32x4){0.f, 0.f, 0.f, 0.f}, a1 = (f32x4){0.f, 0.f, 0.f, 0.f};
#pragma unroll
                    for (int kb = 0; kb < 4; ++kb) { a0 = __builtin_amdgcn_mfma_f32_16x16x32_bf16(xb0[kb], yc[kb], a0, 0, 0, 0); a1 = __builtin_amdgcn_mfma_f32_16x16x32_bf16(xb1[kb], yc[kb], a1, 0, 0, 0); }
#pragma unroll
                    for (int pt = 0; pt < 4; ++pt) { x0[pt] = *(const LAS u32x2*)(lds + L_SXT + (pt * 16 + fr) * SST + (kp * 32 + 4 * fq) * 2);
                        x1[pt] = *(const LAS u32x2*)(lds + L_SXT + (pt * 16 + fr) * SST + (kp * 32 + 16 + 4 * fq) * 2); }
#pragma unroll
                    for (int r = 0; r < 4; ++r) { const int s0 = t0 * 16 + 4 * fq + r, s1 = t1 * 16 + 4 * fq + r;
                        a0[r] = (s0 <= l) ? a0[r] * __expf(acs_l - as0[r]) : 0.f; a1[r] = (do1 && s1 <= l) ? a1[r] * __expf(acs_l - as1[r]) : 0.f; }
                    u32x4 mw; mw.x = cvt_pk_bf16(a0[0], a0[1]); mw.y = cvt_pk_bf16(a0[2], a0[3]); mw.z = cvt_pk_bf16(a1[0], a1[1]); mw.w = cvt_pk_bf16(a1[2], a1[3]);
                    asm volatile("s_nop 1" : "+v"(mw));
                    bf16x8 ym; __builtin_memcpy(&ym, &mw, 16);
#pragma unroll
                    for (int pt = 0; pt < 4; ++pt) { u32x4 xw; xw.x = x0[pt].x; xw.y = x0[pt].y; xw.z = x1[pt].x; xw.w = x1[pt].y;
                        bf16x8 xx; __builtin_memcpy(&xx, &xw, 16);
                        yd[pt] = __builtin_amdgcn_mfma_f32_16x16x32_bf16(xx, ym, yd[pt], 0, 0, 0); }
                }
#pragma unroll
                for (int kh = 0; kh < 2; ++kh) {
                    bf16x8 sfr[2][4];
#pragma unroll
                    for (int k2 = 0; k2 < 2; ++k2)
#pragma unroll
                        for (int pt = 0; pt < 4; ++pt) sfr[k2][pt] = *(const LAS bf16x8*)(lds + L_SST + (pt * 16 + fr) * SST + (kh * 2 + k2) * 64 + fq * 16);
#pragma unroll
                    for (int k2 = 0; k2 < 2; ++k2)
#pragma unroll
                        for (int pt = 0; pt < 4; ++pt) yo[pt] = __builtin_amdgcn_mfma_f32_16x16x32_bf16(sfr[k2][pt], yc[kh * 2 + k2], yo[pt], 0, 0, 0);
                }
                const float el = __expf(acs_l);
                float sq = 0.f;
#pragma unroll
                for (int pt = 0; pt < 4; ++pt) {
                    const u32x2 xw = *(const LAS u32x2*)(lds + L_SX + l * SXS + (pt * 16 + 4 * fq) * 2);
                    const u32x2 zw = zr[pt];
                    float y0 = yd[pt][0] + el * yo[pt][0] + d_h * bf_lo(xw.x), y1 = yd[pt][1] + el * yo[pt][1] + d_h * bf_hi(xw.x);
                    float y2 = yd[pt][2] + el * yo[pt][2] + d_h * bf_lo(xw.y), y3 = yd[pt][3] + el * yo[pt][3] + d_h * bf_hi(xw.y);
                    y0 *= fast_silu(bf_lo(zw.x)); y1 *= fast_silu(bf_hi(zw.x)); y2 *= fast_silu(bf_lo(zw.y)); y3 *= fast_silu(bf_hi(zw.y));
                    sq += (y0 * y0 + y1 * y1) + (y2 * y2 + y3 * y3);
                    u32x2 w; w.x = cvt_pk_bf16(y0, y1); w.y = cvt_pk_bf16(y2, y3);
                    *(u32x2*)(zp + pt * 16) = w;
                }
                sq += __shfl_xor(sq, 16); sq += __shfl_xor(sq, 32);
                if (fq == 0) atomicAdd(ssq + row, sq);
            }
            __syncthreads();
            {
                const float ce = __expf(acs_end);
#pragma unroll
                for (int pt = 0; pt < 4; ++pt) st[pt] = st[pt] * ce;
#pragma unroll
                for (int kh = 0; kh < 2; ++kh) {
                    bf16x8 xb[2], yx[2][4];
#pragma unroll
                    for (int k2 = 0; k2 < 2; ++k2) { xb[k2] = *(const LAS bf16x8*)(lds + L_SM + (l0 + fr) * SST + (kh * 2 + k2) * 64 + fq * 16);
#pragma unroll
                        for (int pt = 0; pt < 4; ++pt) yx[k2][pt] = *(const LAS bf16x8*)(lds + L_SXT + (pt * 16 + fr) * SST + (kh * 2 + k2) * 64 + fq * 16); }
#pragma unroll
                    for (int k2 = 0; k2 < 2; ++k2)
#pragma unroll
                        for (int pt = 0; pt < 4; ++pt) st[pt] = __builtin_amdgcn_mfma_f32_16x16x32_bf16(xb[k2], yx[k2][pt], st[pt], 0, 0, 0);
                }
                asm volatile("s_nop 15\n\ts_nop 15" : "+v"(st[0]), "+v"(st[1]), "+v"(st[2]), "+v"(st[3]));
#pragma unroll
                for (int pt = 0; pt < 4; ++pt) { u32x2 w; w.x = cvt_pk_bf16(st[pt][0], st[pt][1]); w.y = cvt_pk_bf16(st[pt][2], st[pt][3]);
                    *(LAS u32x2*)(lds + L_SST + (pt * 16 + fr) * SST + (l0 + 4 * fq) * 2) = w; }
            }
        }
#undef SSD_PREFETCH
    }
    __syncthreads();
}

__global__ void __launch_bounds__(512, 2) fwd_megakernel(Args a) {
    extern __shared__ __attribute__((aligned(16))) unsigned char lds_raw[];
    LAS unsigned char* lds = (LAS unsigned char*)lds_raw;
    cg::grid_group grid = cg::this_grid();
    const int G = gridDim.x;
    volatile LAS unsigned* barst = (volatile LAS unsigned*)(lds + L_BARST);
    if (threadIdx.x < 2) barst[threadIdx.x] = 0u;
    __syncthreads();
    xcd_barrier_post((unsigned*)(KA(ws) + WS_BAR));
    if (gridDim.x == 0x7fffffffu) grid.sync();
#define GRID_SYNC() xcd_barrier((unsigned*)(KA(ws) + WS_BAR), barst)
#define SSQ ((float*)(KA(ws) + WS_SSQ))
#define W1t ((bf16_t*)(KA(ws) + WS_W + W_W1))
#define W2t ((bf16_t*)(KA(ws) + WS_W + W_W2))
#define WGt ((bf16_t*)(KA(ws) + WS_W + W_GATE))
#define WPt ((bf16_t*)(KA(ws) + WS_W + W_PLE))
#define WAt ((bf16_t*)(KA(ws) + WS_W + W_A))
#define WOt ((bf16_t*)(KA(ws) + WS_W + W_OUT))
#define XB ((bf16_t*)(KA(ws) + WS_XB))
#define PBF ((bf16_t*)(KA(ws) + WS_PBF))
#define DT ((float*)(KA(ws) + WS_DT))
#define BIG ((bf16_t*)(KA(ws) + WS_BIG))
#define PW ((bf16_t*)(KA(ws) + WS_BIG + BIG_PW))
#define XF (KA(out))
#define XB1 ((bf16_t*)KA(out))
#define HALOB ((bf16_t*)(KA(ws) + WS_HALO))

#define ST1 ((float*)(KA(ws) + WS_ST1))
#define ST2 ((float*)(KA(ws) + WS_ST2))
#define UVP(layer, off) ((float*)(KA(ws) + WS_UV) + (layer) * UV_LAYER + (off))
    {
        const int tid = launder((int)threadIdx.x), gt = blockIdx.x * 512 + tid, ngt = launder_s(G) * 512;
        pool_phase(KA(x), BIG, gt, ngt);
        cvt_rows(KA(p), PBF, (size_t)2 * MROWS * PLED / 4, gt, ngt);
    }
#define PREPASS_VARS() const int tid = launder((int)threadIdx.x), lane = tid & 63, wave = __builtin_amdgcn_readfirstlane(tid >> 6); \
        const int gw = blockIdx.x * 8 + wave, gt = blockIdx.x * 512 + tid, ngw = launder_s(G) * 8, ngt = launder_s(G) * 512; \
        LAS float* scr = (LAS float*)(lds + wave * 16384); (void)gt; (void)ngt
#define PREPASS_MAIN(L) do { PREPASS_VARS(); \
        transpose_matrix(KA(w1) + (size_t)(L) * DM * DFF, DM, DFF, W1t, 0, scr, gw, ngw, lane, \
                         KA(ln_g) + (size_t)((L) * 2 + 0) * DM, KA(ln_b) + (size_t)((L) * 2 + 0) * DM, UVP((L), UV_U1), UVP((L), UV_V1)); \
        transpose_matrix(KA(w2) + (size_t)(L) * DFF * DM, DFF, DM, W2t, 0, scr, gw, ngw, lane); \
        if ((L) == 0) { for (int gi = 0; gi < 4; ++gi) transpose_matrix(KA(pool_w) + (size_t)gi * 512 * 512, 512, 512, WAt, gi * 512, scr, gw, ngw, lane); } \
        else { transpose_matrix(KA(ssm_in_w), DM, NIN, WAt, 0, scr, gw, ngw, lane); \
               transpose_matrix(KA(out_w), DIN, DM, WOt, 0, scr, gw, ngw, lane, KA(norm_w)); } } while (0)
#define PREPASS_LATE(L) do { PREPASS_VARS(); \
        transpose_matrix(KA(gate_w) + (size_t)(L) * DM * DM, DM, DM, WGt, 0, scr, gw, ngw, lane, \
                         KA(ln_g) + (size_t)((L) * 2 + 1) * DM, KA(ln_b) + (size_t)((L) * 2 + 1) * DM, UVP((L), UV_UG), UVP((L), UV_VG)); \
        transpose_matrix(KA(ple_w) + (size_t)(L) * PLED * DM, PLED, DM, WPt, 0, scr, gw, ngw, lane); \
        if ((L) == 1) { float* const zp = ST1; for (int i = gt; i < 4 * MROWS; i += ngt) zp[i] = 0.f; } } while (0)
    PREPASS_MAIN(0);
    PREPASS_LATE(0);
    GRID_SYNC();
    for (int layer = 0; layer < 2; ++layer) {
        if (layer == 0) {
            pg8::Gemm g{BIG, WAt, DM, 512, 512, 2, 512}; pg8::StaticOrder S; S.init(MROWS, DM, launder_s(G), launder_s((int)blockIdx.x));
            pg8::EpiRes<0> E{XF, XB, KA(x), KA(pool_scale), nullptr, nullptr, nullptr, ST1, nullptr, nullptr, nullptr, nullptr, XB, 0};
            pg8::gemm_phase(lds, g, S, E);
            GRID_SYNC();
        } else {
            PREPASS_LATE(1);
            __syncthreads();
            { pg8::Gemm g{XB1, WAt, DM, DM, DM, 1 << 20, 0}; pg8::StaticOrder S; S.init(MROWS, ZXW, launder_s(G), launder_s((int)blockIdx.x));
              pg8::EpiInProj E{BIG, DT, KA(dt_bias), HALOB};
              pg8::gemm_phase(lds, g, S, E); }
            GRID_SYNC();
            dt_phase(XB1, WAt, KA(dt_bias), DT, 0, 2 * (MROWS / 16));
            conv_phase(BIG, HALOB, KA(conv_w), KA(conv_b));
            GRID_SYNC();
            ssd_phase(lds, BIG, DT, KA(a_log), KA(d_skip), KA(norm_w), SSQ);
            GRID_SYNC();
            { pg8::Gemm g{BIG, WOt, ZXW, DIN, DIN, 1 << 20, 0}; pg8::StaticOrder S; S.init(MROWS, DM, launder_s(G), launder_s((int)blockIdx.x));
              pg8::EpiRes<2> E{XF, XB, nullptr, nullptr, SSQ, nullptr, nullptr, ST1, nullptr, nullptr, nullptr, nullptr, XB1, 0};
              pg8::gemm_phase(lds, g, S, E); }
            GRID_SYNC();
        }
        for (int step = 0; step < 3; ++step) {
            if (step > 0) {
                const int pmh = (step - 1) * (MROWS / 512);
                pg8::Gemm g{BIG, W2t, DFF, DFF, DFF, 1 << 20, 0}; pg8::StaticOrder S; S.init(MROWS / 2, DM, launder_s(G), launder_s((int)blockIdx.x), pmh);
                pg8::EpiRes<1> E{XF, XB, nullptr, nullptr, nullptr, nullptr, ST1, ST2, KA(ln_g) + (size_t)(layer * 2 + 0) * DM, KA(ln_b) + (size_t)(layer * 2 + 0) * DM, nullptr, nullptr, XB, 0};
                pg8::gemm_phase(lds, g, S, E);
            }
            if (step < 2) {
                const int pmh = step * (MROWS / 512);
                pg8::Gemm g{XB, W1t, DM, DM, DM, 1 << 20, 0}; pg8::StaticOrder S; S.init(MROWS / 2, DFF, launder_s(G), launder_s((int)blockIdx.x), pmh);
                pg8::EpiUp E{BIG, ST1, UVP(layer, UV_U1), UVP(layer, UV_V1)};
                pg8::gemm_phase(lds, g, S, E);
            }
            GRID_SYNC();
        }
        { pg8::Gemm g{PBF + (size_t)layer * MROWS * PLED, WPt, PLED, PLED, PLED, 1 << 20, 0}; pg8::StaticOrder S; S.init(MROWS, DM, launder_s(G), launder_s((int)blockIdx.x));
          pg8::EpiBf16<0> E{PW, DM};
          pg8::gemm_phase(lds, g, S, E); }
        { pg8::Gemm g{XB, WGt, DM, DM, DM, 1 << 20, 0}; pg8::StaticOrder S; S.init(MROWS, DM, launder_s(G), launder_s((int)blockIdx.x));
          pg8::EpiRes<3> E{XF, layer == 0 ? XB1 : XB, nullptr, nullptr, nullptr, PW, ST2, nullptr, KA(ln_g) + (size_t)(layer * 2 + 1) * DM, KA(ln_b) + (size_t)(layer * 2 + 1) * DM, UVP(layer, UV_UG), UVP(layer, UV_VG), XB, layer == 0 ? 1 : 0};
          pg8::gemm_phase(lds, g, S, E); }
        if (layer == 0) { PREPASS_MAIN(1); GRID_SYNC(); }
    }
}

extern "C" void kernel_launch(void* const* d_in, const int* in_sizes, int n_in, void* d_out, int out_size, void* d_ws, size_t ws_size, hipStream_t stream) {
    static int grid = 0;
    if (grid == 0) {
        if (n_in != 18 || in_sizes[0] != MROWS * DM || out_size != MROWS * DM || ws_size < WS_END) {
            fprintf(stderr, "kernel_launch: unexpected shapes (n_in %d, in0 %d, out %d, ws %zu, need %zu); nothing launched\n", n_in, n_in > 0 ? in_sizes[0] : -1, out_size, ws_size, (size_t)WS_END);
            grid = -1; return; }
        int dev = 0, cus = 0, per_cu = 0;
        if (hipGetDevice(&dev) != hipSuccess || hipDeviceGetAttribute(&cus, hipDeviceAttributeMultiprocessorCount, dev) != hipSuccess) { grid = -1; return; }
        if (hipFuncSetAttribute((const void*)fwd_megakernel, hipFuncAttributeMaxDynamicSharedMemorySize, LDS_BYTES) != hipSuccess) { fprintf(stderr, "kernel_launch: hipFuncSetAttribute failed\n"); grid = -1; return; }
        if (hipOccupancyMaxActiveBlocksPerMultiprocessor(&per_cu, (const void*)fwd_megakernel, 512, LDS_BYTES) != hipSuccess || per_cu < 1) { fprintf(stderr, "kernel_launch: occupancy query says %d blocks per CU\n", per_cu); per_cu = 1; }
        (void)hipGetLastError();
        grid = cus;
    }
    if (grid < 0) return;
    Args a{};
    a.x = (const float*)d_in[0]; a.p = (const float*)d_in[1]; a.pool_w = (const float*)d_in[2]; a.pool_scale = (const float*)d_in[3]; a.ssm_in_w = (const float*)d_in[4];
    a.conv_w = (const float*)d_in[5]; a.conv_b = (const float*)d_in[6]; a.dt_bias = (const float*)d_in[7]; a.a_log = (const float*)d_in[8]; a.d_skip = (const float*)d_in[9];
    a.norm_w = (const float*)d_in[10]; a.out_w = (const float*)d_in[11]; a.w1 = (const float*)d_in[12]; a.w2 = (const float*)d_in[13]; a.ln_g = (const float*)d_in[14];
    a.ln_b = (const float*)d_in[15]; a.ple_w = (const float*)d_in[16]; a.gate_w = (const float*)d_in[17];
    a.out = (float*)d_out; a.ws = (unsigned char*)d_ws;
    if (hipMemsetAsync(d_ws, 0, WS_W, stream) != hipSuccess) { fprintf(stderr, "kernel_launch: hipMemsetAsync failed\n"); return; }
    void* args[] = {&a};
    const hipError_t e = hipLaunchCooperativeKernel((const void*)fwd_megakernel, dim3(grid), dim3(512), args, LDS_BYTES, stream);
    if (e != hipSuccess) fprintf(stderr, "kernel_launch: cooperative launch failed: %s (grid %d)\n", hipGetErrorString(e), grid);
}
```

```cpp
#include <hip/hip_runtime.h>
#include <hip/hip_cooperative_groups.h>
#include <cstdio>
#include <cstdint>
namespace cg = cooperative_groups;

#define LAS __attribute__((address_space(3)))
typedef unsigned short bf16_t;
typedef short bf16x8 __attribute__((ext_vector_type(8)));
typedef float f32x4 __attribute__((ext_vector_type(4)));
typedef float f32x2 __attribute__((ext_vector_type(2)));
typedef unsigned u32x4 __attribute__((ext_vector_type(4)));
typedef unsigned u32x2 __attribute__((ext_vector_type(2)));

constexpr int MROWS = 16384, DM = 2048, DFF = 8192, DIN = 4096, ZXW = 10240, NINP = 10496, NIN = 10304, SEQL = 2048, NB = 8, PLED = 256;
constexpr int NHEAD = 64, HDIM = 64, NGRP = 8, DSTATE = 128, CONVD = 6144, CHUNKL = 128, NCHUNK = 16;
constexpr float ALPHA_F = 1.41421356237309515f;
constexpr float LN_EPS_F = 1e-5f, RMS_EPS_F = 1e-5f;

constexpr size_t MiB = 1024 * 1024;
constexpr size_t WS_SSQ = 0;
constexpr size_t WS_BAR = 131072;
constexpr size_t WS_ST1 = 262144, WS_ST2 = 393216;
constexpr size_t WS_UV = 524288;
constexpr int UV_LAYER = 20480, UV_U1 = 0, UV_V1 = 8192, UV_UG = 16384, UV_VG = 18432;
constexpr size_t WS_W = 1 * MiB;
constexpr size_t W_W1 = 0, W_W2 = 33554432, W_GATE = 67108864, W_PLE = 75497472, W_A = 76546048, W_OUT = 119537664, W_END = 136314880;
constexpr size_t WS_XB = WS_W + W_END;
constexpr size_t WS_PBF = WS_XB + 67108864;
constexpr size_t WS_DT = WS_PBF + 16777216;
constexpr size_t WS_BIG = WS_DT + 4194304;
constexpr size_t BIG_PW = 268435456;
constexpr size_t WS_HALO = WS_BIG + 335544320;
constexpr size_t WS_END = WS_HALO + (size_t)128 * 3 * 6144 * 2;

constexpr int LDS_BYTES = 163840, L_BARST = 163824;

typedef __bf16 bf16x2_t __attribute__((ext_vector_type(2)));
__device__ __forceinline__ unsigned cvt_pk_bf16(float lo, float hi) { const f32x2 v = {lo, hi}; const bf16x2_t b = __builtin_convertvector(v, bf16x2_t); unsigned r; __builtin_memcpy(&r, &b, 4); return r; }
__device__ __forceinline__ float bf_lo(unsigned w) { return __uint_as_float(w << 16); }
__device__ __forceinline__ float bf_hi(unsigned w) { return __uint_as_float(w & 0xffff0000u); }
__device__ __forceinline__ float wave_sum(float v) {
#pragma unroll
    for (int o = 1; o < 64; o <<= 1) v += __shfl_xor(v, o);
    return v;
}
__device__ __forceinline__ float rdlane(float v, int l) { return __int_as_float(__builtin_amdgcn_readlane(__float_as_int(v), l)); }
__device__ __forceinline__ float fast_sigmoid(float v) { return __builtin_amdgcn_rcpf(1.0f + __expf(-v)); }
__device__ __forceinline__ float fast_silu(float v) { return v * fast_sigmoid(v); }
#define LDS_WAIT() asm volatile("s_waitcnt lgkmcnt(0)" ::: "memory")
__device__ __forceinline__ int launder_s(int v) { asm volatile("" : "+s"(v)); return v; }
__device__ __forceinline__ int launder(int v) { asm volatile("" : "+v"(v)); return v; }


#define XB_TMO      128
#define XB_XCNT(j)  (256  + 64 * (j))
#define XB_XSUB(j)  (1280 + 64 * (j))
#define XB_XGEN(j)  (2304 + 64 * (j))
#define XB_TOP      3328
#define XB_TOPGEN   3392
#define XCD_BAR_WORDS 3456
#define XB_SPIN_CAP (1u << 20)
__device__ __forceinline__ unsigned xb_ld(unsigned* p)              { return __hip_atomic_load(p, __ATOMIC_RELAXED, __HIP_MEMORY_SCOPE_AGENT); }
__device__ __forceinline__ unsigned xb_add(unsigned* p, unsigned v) { return __hip_atomic_fetch_add(p, v, __ATOMIC_RELAXED, __HIP_MEMORY_SCOPE_AGENT); }
__device__ __forceinline__ unsigned xb_xcc_id() { return (unsigned)__builtin_amdgcn_s_getreg((3 << 11) | 20) & 0xFu; }
#define XB_SPIN(cond, bar) do { unsigned _sp = 0; while (cond) { __builtin_amdgcn_s_sleep(1); \
    if ((++_sp & 255u) == 0u) { if (xb_ld(&(bar)[XB_TMO])) break; if (_sp > XB_SPIN_CAP) { atomicAdd(&(bar)[XB_TMO], 1u); break; } } } } while (0)
__device__ __forceinline__ void xcd_barrier_post(unsigned* bar) { if (threadIdx.x == 0) (void)xb_add(&bar[XB_XCNT(xb_xcc_id())], 1u); }
__device__ __forceinline__ void xcd_barrier_complete(unsigned* bar, unsigned x, unsigned& nloc, unsigned& nx) {
    const unsigned G = gridDim.x;
    unsigned sum, cnt, mine, sp = 0u;
    for (;;) {
        sum = 0u; cnt = 0u; mine = 0u;
#pragma unroll
        for (unsigned j = 0; j < 16; ++j) { const unsigned c = xb_ld(&bar[XB_XCNT(j)]); sum += c; cnt += (c > 0u) ? 1u : 0u; mine = (j == x) ? c : mine; }
        if (sum == G) break;
        __builtin_amdgcn_s_sleep(1);
        if ((++sp & 255u) == 0u) { if (xb_ld(&bar[XB_TMO])) break; if (sp > XB_SPIN_CAP) { atomicAdd(&bar[XB_TMO], 1u); break; } }
    }
    nloc = mine > 0u ? mine : 1u; nx = cnt > 0u ? cnt : 1u;
}
__device__ __forceinline__ void xcd_barrier(unsigned* bar, volatile LAS unsigned* st) {
    asm volatile("s_waitcnt vmcnt(0)" ::: "memory");
    __syncthreads();
    if (threadIdx.x == 0) {
        __builtin_amdgcn_s_waitcnt(0);
        const unsigned x = xb_xcc_id();
        unsigned nloc = st[0], nx = st[1];
        if (nloc == 0u) { xcd_barrier_complete(bar, x, nloc, nx); st[0] = nloc; st[1] = nx; }
        const unsigned old = xb_add(&bar[XB_XSUB(x)], 1u);
        const unsigned gen = old / nloc;
        if (old + 1u == (gen + 1u) * nloc) {
            __builtin_amdgcn_fence(__ATOMIC_RELEASE, "agent");
            asm volatile("s_waitcnt vmcnt(0)" ::: "memory");
            const unsigned og = xb_add(&bar[XB_TOP], 1u);
            const unsigned tg = og / nx;
            if (og + 1u == (tg + 1u) * nx) xb_add(&bar[XB_TOPGEN], 1u);
            else XB_SPIN(xb_ld(&bar[XB_TOPGEN]) == tg, bar);
            __builtin_amdgcn_fence(__ATOMIC_ACQUIRE, "agent");
            xb_add(&bar[XB_XGEN(x)], 1u);
            asm volatile("s_waitcnt vmcnt(0)" ::: "memory");
        } else {
            XB_SPIN(xb_ld(&bar[XB_XGEN(x)]) == gen, bar);
            __builtin_amdgcn_fence(__ATOMIC_ACQUIRE, "agent");
            asm volatile("s_waitcnt vmcnt(0)" ::: "memory");
        }
    }
    __syncthreads();
}

namespace pg8 {
constexpr int BM = 256, BK = 64, HALF = 128, HTB = HALF * BK * 2, STAGE_BYTES = 8 * HTB, NXCD = 8, WGM = 8;
__host__ __device__ __forceinline__ int lds_byte(int r, int c) { const int st = (r >> 4) * 2 + (c >> 5), rr = r & 15, cc = c & 31, ob = rr * 64 + cc * 2; return st * 1024 + (ob ^ (((ob >> 9) & 1) << 5)); }
__host__ __device__ __forceinline__ void stage_rc(int b, int& R, int& C) { const int st = b / 1024, sb = b % 1024, swz = sb ^ (((sb >> 9) & 1) << 5); R = (st >> 1) * 16 + swz / 64; C = (st & 1) * 32 + (swz % 64) / 2; }
__host__ __device__ __forceinline__ int perm32(int rho) { const int n = rho >> 4, i = rho & 15; return 8 * (i >> 2) + 4 * n + (i & 3); }

struct Unit { int pm, pn; };
struct Gemm { const bf16_t* A; const bf16_t* Bt; int lda, ldb, K, tpg, goff; };

struct StaticOrder {
    int nM, nN, nwg, G, c, pm0;
    __device__ void init(int M, int N, int G_, int c_, int pm0_ = 0) { nM = M / BM; nN = N / BM; nwg = nM * nN; G = G_; c = c_; pm0 = pm0_; }
    __device__ bool next(int i, Unit& u) const {
        const long L = (long)i * G + c; if (L >= nwg) return false;
        int wgid = (int)L; { const int q = nwg / NXCD, r = nwg % NXCD, xcd = wgid % NXCD, off = wgid / NXCD; wgid = (xcd < r ? xcd * (q + 1) : r * (q + 1) + (xcd - r) * q) + off; }
        const int nig = WGM * nN, gid = wgid / nig, fm = gid * WGM, gsz = (nM - fm) < WGM ? (nM - fm) : WGM;
        u.pm = pm0 + fm + ((wgid % nig) % gsz); u.pn = (wgid % nig) / gsz; return true;
    }
};

template <int ACT  > struct EpiBf16 {
    static constexpr bool PERM = true;
    bf16_t* O; int ldc;
    __device__ __forceinline__ void operator()(const f32x4 (&acc)[2][2][4][2], const Unit& u, int wr, int wc, int fr, int fq) const {
        const int row0 = u.pm * BM + wr * 64 + fr, col0 = u.pn * BM + wc * 32 + 8 * fq;
#pragma unroll
        for (int ai = 0; ai < 2; ++ai)
#pragma unroll
            for (int m = 0; m < 4; ++m) { bf16_t* rowp = O + (size_t)(row0 + ai * HALF + m * 16) * ldc + col0;
#pragma unroll
                for (int bj = 0; bj < 2; ++bj) { f32x4 v0 = acc[ai][bj][m][0], v1 = acc[ai][bj][m][1];
                    if (ACT == 1) {
#pragma unroll
                        for (int j = 0; j < 4; ++j) { const float a = fmaxf(v0[j], 0.f), b = fmaxf(v1[j], 0.f); v0[j] = a * a; v1[j] = b * b; }
                        asm volatile("" : "+v"(v0), "+v"(v1)); }
                    u32x4 w; w.x = cvt_pk_bf16(v0[0], v0[1]); w.y = cvt_pk_bf16(v0[2], v0[3]); w.z = cvt_pk_bf16(v1[0], v1[1]); w.w = cvt_pk_bf16(v1[2], v1[3]);
                    *(u32x4*)(rowp + bj * HALF) = w; }
                asm volatile("" ::: "memory"); }
    }
};
struct EpiInProj {
    static constexpr bool PERM = true;
    bf16_t* O; float* DT; const float* dt_bias; bf16_t* HALO;
    __device__ __forceinline__ void operator()(const f32x4 (&acc)[2][2][4][2], const Unit& u, int wr, int wc, int fr, int fq) const {
        const int row0 = u.pm * BM + wr * 64 + fr;
        if (u.pn < 40) {
            const int col0 = u.pn * BM + wc * 32 + 8 * fq;
            const bool halo_lane = (u.pn >= 16) && (wr == 1) && (fr >= 13);
#pragma unroll
            for (int ai = 0; ai < 2; ++ai)
#pragma unroll
                for (int m = 0; m < 4; ++m) { const int row = row0 + ai * HALF + m * 16; bf16_t* rowp = O + (size_t)row * ZXW + col0;
#pragma unroll
                    for (int bj = 0; bj < 2; ++bj) { const f32x4 v0 = acc[ai][bj][m][0], v1 = acc[ai][bj][m][1];
                        u32x4 w; w.x = cvt_pk_bf16(v0[0], v0[1]); w.y = cvt_pk_bf16(v0[2], v0[3]); w.z = cvt_pk_bf16(v1[0], v1[1]); w.w = cvt_pk_bf16(v1[2], v1[3]);
                        *(u32x4*)(rowp + bj * HALF) = w;
                        if (m == 3 && halo_lane) *(u32x4*)(HALO + ((size_t)(row >> 7) * 3 + (fr - 13)) * CONVD + (col0 + bj * HALF - DIN)) = w; } }
        } else if (wc < 2) {
            const int c0 = wc * 32 + 8 * fq;
            const f32x4 b0 = *(const f32x4*)(dt_bias + c0), b1 = *(const f32x4*)(dt_bias + c0 + 4);
#pragma unroll
            for (int ai = 0; ai < 2; ++ai)
#pragma unroll
                for (int m = 0; m < 4; ++m) { float* rowp = DT + (size_t)(row0 + ai * HALF + m * 16) * 64 + c0;
                    f32x4 v0 = acc[ai][0][m][0] + b0, v1 = acc[ai][0][m][1] + b1;
#pragma unroll
                    for (int j = 0; j < 4; ++j) { v0[j] = v0[j] > 20.f ? v0[j] : log1pf(__expf(v0[j])); v1[j] = v1[j] > 20.f ? v1[j] : log1pf(__expf(v1[j])); }
                    *(f32x4*)rowp = v0; *(f32x4*)(rowp + 4) = v1; }
        }
    }
};
__device__ __forceinline__ void ln_row_stats(const float* st, int row, float& mu, float& rstd) {
    const f32x2 sv = *(const f32x2*)(st + 2 * (size_t)row); mu = sv[0] * (1.0f / DM); const float var = sv[1] * (1.0f / DM) - mu * mu; rstd = __builtin_amdgcn_rsqf(fmaxf(var, 0.f) + LN_EPS_F);
}
template <int MODE> struct EpiRes {
    static constexpr bool PERM = true;
    float* XFp; bf16_t* XBo; const float* xin; const float* scale; const float* ssq; const bf16_t* PWp;
    const float* st_in; float* st_out; const float* lg; const float* lb; const float* uu; const float* vv;
    const bf16_t* XBi; int out_bf16;
    __device__ __forceinline__ void operator()(const f32x4 (&acc)[2][2][4][2], const Unit& u, int wr, int wc, int fr, int fq) const {
        const int row0 = u.pm * BM + wr * 64 + fr, col0 = u.pn * BM + wc * 32 + 8 * fq;
        float mu[8], rstd[8], s1[8], s2[8];
#pragma unroll
        for (int i = 0; i < 8; ++i) { const int row = row0 + (i >> 2) * HALF + (i & 3) * 16; mu[i] = 0.f; rstd[i] = 1.f; s1[i] = 0.f; s2[i] = 0.f;
            if (MODE == 1 || MODE == 3) ln_row_stats(st_in, row, mu[i], rstd[i]);
            if (MODE == 2) rstd[i] = __builtin_amdgcn_rsqf(ssq[row] * (1.0f / DIN) + RMS_EPS_F); }
#pragma unroll
        for (int bj = 0; bj < 2; ++bj) { const int cc = col0 + bj * HALF;
            f32x4 g0, g1, b0, b1, u0, u1, v0, v1;
            if (MODE == 0) { g0 = *(const f32x4*)(scale + cc); g1 = *(const f32x4*)(scale + cc + 4); }
            if (MODE == 1 || MODE == 3) { g0 = *(const f32x4*)(lg + cc); g1 = *(const f32x4*)(lg + cc + 4); b0 = *(const f32x4*)(lb + cc); b1 = *(const f32x4*)(lb + cc + 4); }
            if (MODE == 3) { u0 = *(const f32x4*)(uu + cc); u1 = *(const f32x4*)(uu + cc + 4); v0 = *(const f32x4*)(vv + cc); v1 = *(const f32x4*)(vv + cc + 4); }
#pragma unroll
            for (int i = 0; i < 8; ++i) { const int ai = i >> 2, m = i & 3; const size_t o = (size_t)(row0 + ai * HALF + m * 16) * DM + cc;
                const f32x4 a0 = acc[ai][bj][m][0], a1 = acc[ai][bj][m][1]; f32x4 r0, r1, t0, t1;
                if (MODE == 0) { t0 = *(const f32x4*)(xin + o); t1 = *(const f32x4*)(xin + o + 4); r0 = t0 * ALPHA_F + a0 * g0; r1 = t1 * ALPHA_F + a1 * g1; }
                if (MODE != 0) { const u32x4 tw = *(const u32x4*)(XBi + o);
                    t0 = (f32x4){bf_lo(tw.x), bf_hi(tw.x), bf_lo(tw.y), bf_hi(tw.y)}; t1 = (f32x4){bf_lo(tw.z), bf_hi(tw.z), bf_lo(tw.w), bf_hi(tw.w)}; }
                if (MODE == 1) { r0 = ((t0 - mu[i]) * rstd[i] * g0 + b0) * ALPHA_F + a0; r1 = ((t1 - mu[i]) * rstd[i] * g1 + b1) * ALPHA_F + a1; }
                if (MODE == 2) { r0 = t0 * ALPHA_F + a0 * rstd[i]; r1 = t1 * ALPHA_F + a1 * rstd[i]; }
                if (MODE == 3) { const u32x4 pw = *(const u32x4*)(PWp + o);
                    const f32x4 x0 = (t0 - mu[i]) * rstd[i] * g0 + b0, x1 = (t1 - mu[i]) * rstd[i] * g1 + b1;
                    const f32x4 p0 = (a0 - u0 * mu[i]) * rstd[i] + v0, p1 = (a1 - u1 * mu[i]) * rstd[i] + v1;
                    r0[0] = x0[0] + fast_sigmoid(p0[0]) * bf_lo(pw.x); r0[1] = x0[1] + fast_sigmoid(p0[1]) * bf_hi(pw.x); r0[2] = x0[2] + fast_sigmoid(p0[2]) * bf_lo(pw.y); r0[3] = x0[3] + fast_sigmoid(p0[3]) * bf_hi(pw.y);
                    r1[0] = x1[0] + fast_sigmoid(p1[0]) * bf_lo(pw.z); r1[1] = x1[1] + fast_sigmoid(p1[1]) * bf_hi(pw.z); r1[2] = x1[2] + fast_sigmoid(p1[2]) * bf_lo(pw.w); r1[3] = x1[3] + fast_sigmoid(p1[3]) * bf_hi(pw.w);
                    if (out_bf16) { u32x4 w; w.x = cvt_pk_bf16(r0[0], r0[1]); w.y = cvt_pk_bf16(r0[2], r0[3]); w.z = cvt_pk_bf16(r1[0], r1[1]); w.w = cvt_pk_bf16(r1[2], r1[3]); *(u32x4*)(XBo + o) = w; }
                    else { *(f32x4*)(XFp + o) = r0; *(f32x4*)(XFp + o + 4) = r1; } }
                if (MODE != 3) { u32x4 w; w.x = cvt_pk_bf16(r0[0], r0[1]); w.y = cvt_pk_bf16(r0[2], r0[3]); w.z = cvt_pk_bf16(r1[0], r1[1]); w.w = cvt_pk_bf16(r1[2], r1[3]);
                    *(u32x4*)(XBo + o) = w;
                    const float q0 = bf_lo(w.x), q1 = bf_hi(w.x), q2 = bf_lo(w.y), q3 = bf_hi(w.y), q4 = bf_lo(w.z), q5 = bf_hi(w.z), q6 = bf_lo(w.w), q7 = bf_hi(w.w);
                    s1[i] += ((q0 + q1) + (q2 + q3)) + ((q4 + q5) + (q6 + q7)); s2[i] += ((q0 * q0 + q1 * q1) + (q2 * q2 + q3 * q3)) + ((q4 * q4 + q5 * q5) + (q6 * q6 + q7 * q7)); } }
            asm volatile("" ::: "memory"); }
        if (MODE != 3) {
#pragma unroll
            for (int i = 0; i < 8; ++i) { float a1 = s1[i], a2 = s2[i]; a1 += __shfl_xor(a1, 16); a1 += __shfl_xor(a1, 32); a2 += __shfl_xor(a2, 16); a2 += __shfl_xor(a2, 32);
                const int row = row0 + (i >> 2) * HALF + (i & 3) * 16;
                if (fq < 2) atomicAdd(st_out + 2 * (size_t)row + fq, fq == 0 ? a1 : a2); }
        }
    }
};
struct EpiUp {
    static constexpr bool PERM = true;
    bf16_t* O; const float* st_in; const float* uu; const float* vv;
    __device__ __forceinline__ void operator()(const f32x4 (&acc)[2][2][4][2], const Unit& u, int wr, int wc, int fr, int fq) const {
        const int row0 = u.pm * BM + wr * 64 + fr, col0 = u.pn * BM + wc * 32 + 8 * fq;
        float mu[8], rstd[8];
#pragma unroll
        for (int i = 0; i < 8; ++i) ln_row_stats(st_in, row0 + (i >> 2) * HALF + (i & 3) * 16, mu[i], rstd[i]);
#pragma unroll
        for (int bj = 0; bj < 2; ++bj) { const int cc = col0 + bj * HALF;
            const f32x4 u0 = *(const f32x4*)(uu + cc), u1 = *(const f32x4*)(uu + cc + 4), w0 = *(const f32x4*)(vv + cc), w1 = *(const f32x4*)(vv + cc + 4);
#pragma unroll
            for (int i = 0; i < 8; ++i) { const int ai = i >> 2, m = i & 3;
                const float mr = mu[i] * rstd[i];
                f32x4 v0 = acc[ai][bj][m][0] * rstd[i] + (w0 - u0 * mr), v1 = acc[ai][bj][m][1] * rstd[i] + (w1 - u1 * mr);
#pragma unroll
                for (int j = 0; j < 4; ++j) { const float a = fmaxf(v0[j], 0.f), b = fmaxf(v1[j], 0.f); v0[j] = a * a; v1[j] = b * b; }
                u32x4 w; w.x = cvt_pk_bf16(v0[0], v0[1]); w.y = cvt_pk_bf16(v0[2], v0[3]); w.z = cvt_pk_bf16(v1[0], v1[1]); w.w = cvt_pk_bf16(v1[2], v1[3]);
                *(u32x4*)(O + (size_t)(row0 + ai * HALF + m * 16) * DFF + cc) = w; }
            asm volatile("" ::: "memory"); }
    }
};

template <class Epi>
__device__ __forceinline__ void gemm_phase(LAS unsigned char* lds, const Gemm g, const StaticOrder& S, const Epi& E) {
    const int tid = launder((int)threadIdx.x), wid = __builtin_amdgcn_readfirstlane(tid >> 6), lane = tid & 63, wr = wid >> 2, wc = wid & 3, fr = lane & 15, fq = lane >> 4;
    int nt = g.K / BK; asm volatile("" : "+s"(nt));
    unsigned voffA[2], voffB[2];
#pragma unroll
    for (int i = 0; i < 2; ++i) { int R, C; stage_rc(tid * 16 + i * 8192, R, C); const int Rb = Epi::PERM ? ((R & ~31) + perm32(R & 31)) : R;
        voffA[i] = (unsigned)(R * g.lda + C) * 2u; voffB[i] = (unsigned)(Rb * g.ldb + C) * 2u; }
    const size_t kstep = (size_t)(BK * 2);
    const size_t hstepA = (size_t)HALF * g.lda * 2, hstepB = (size_t)HALF * g.ldb * 2;
    const unsigned ldsw = (unsigned)wid * 1024u;
    const int aoff = lds_byte(wr * 64 + fr, fq * 8), boff = lds_byte(wc * 32 + fr, fq * 8);
#define PG8_APTR(u) ((const char*)g.A + (size_t)(u).pm * 2 * hstepA + (size_t)((u).pn / g.tpg) * (size_t)g.goff * 2)
#define PG8_BPTR(u) ((const char*)g.Bt + (size_t)(u).pn * 2 * hstepB)
#define PG8_SA(b, h) (((b) * 2 + (h)) * HTB)
#define PG8_SB(b, h) ((4 + (b) * 2 + (h)) * HTB)
#define PG8_STAGE(bufoff, gbase, voff) do { _Pragma("unroll") for (int _i = 0; _i < 2; ++_i) \
        __builtin_amdgcn_global_load_lds((const unsigned*)((const char*)(gbase) + (voff)[_i]), (LAS unsigned*)(lds + (bufoff) + ldsw + _i * 8192), 16, 0, 0); } while (0)
#define PG8_LDA(dst, b, h) do { _Pragma("unroll") for (int m = 0; m < 4; ++m) _Pragma("unroll") for (int k = 0; k < 2; ++k) dst[m][k] = *(const LAS bf16x8*)(lds + PG8_SA(b, h) + aoff + m * 2048 + k * 1024); } while (0)
#define PG8_LDB(dst, b, h) do { _Pragma("unroll") for (int n = 0; n < 2; ++n) _Pragma("unroll") for (int k = 0; k < 2; ++k) dst[n][k] = *(const LAS bf16x8*)(lds + PG8_SB(b, h) + boff + n * 2048 + k * 1024); } while (0)
#define PG8_MMA(ai, bj, At, Bt) do { __builtin_amdgcn_s_setprio(1); _Pragma("unroll") for (int m = 0; m < 4; ++m) _Pragma("unroll") for (int n = 0; n < 2; ++n) _Pragma("unroll") for (int k = 0; k < 2; ++k) \
        acc[ai][bj][m][n] = __builtin_amdgcn_mfma_f32_16x16x32_bf16(Bt[n][k], At[m][k], acc[ai][bj][m][n], 0, 0, 0); __builtin_amdgcn_s_setprio(0); } while (0)
#define PG8_WAIT_V(n) asm volatile("s_waitcnt vmcnt(" #n ")" ::: "memory")
#define PG8_WAIT_L(n) asm volatile("s_waitcnt lgkmcnt(" #n ")" ::: "memory")
#define PG8_BAR __builtin_amdgcn_s_barrier()
#define PG8_SCHED __builtin_amdgcn_sched_barrier(0)
    Unit cur, nxt; int ui = 0;
    if (!S.next(0, cur)) return;
    f32x4 acc[2][2][4][2];
#pragma unroll
    for (int a = 0; a < 2; ++a)
#pragma unroll
        for (int b = 0; b < 2; ++b)
#pragma unroll
            for (int m = 0; m < 4; ++m)
#pragma unroll
                for (int n = 0; n < 2; ++n) acc[a][b][m][n] = (f32x4){0.f, 0.f, 0.f, 0.f};
    bf16x8 At[4][2], B0[2][2], B1[2][2];
    const char* cA = PG8_APTR(cur); const char* cB = PG8_BPTR(cur);
    PG8_STAGE(PG8_SB(0, 0), cB, voffB); PG8_STAGE(PG8_SB(0, 1), cB + hstepB, voffB); PG8_STAGE(PG8_SA(0, 0), cA, voffA); PG8_STAGE(PG8_SA(0, 1), cA + hstepA, voffA);
    if (wr == 1) PG8_BAR;
    PG8_WAIT_V(2); PG8_BAR;
    PG8_STAGE(PG8_SB(1, 0), cB + kstep, voffB); PG8_STAGE(PG8_SA(1, 0), cA + kstep, voffA); PG8_STAGE(PG8_SB(1, 1), cB + hstepB + kstep, voffB);
    PG8_WAIT_V(6); PG8_BAR;
    for (;;) {
        const bool has_next = S.next(ui + 1, nxt);
        const char* nA = has_next ? PG8_APTR(nxt) : cA; const char* nB = has_next ? PG8_BPTR(nxt) : cB;
        for (int t = 0; t < nt; t += 2) {
            const bool last = (t == nt - 2);
            const char* a1 = cA + (size_t)(t + 1) * kstep;
            const char* a2 = last ? nA : cA + (size_t)(t + 2) * kstep; const char* b2 = last ? nB : cB + (size_t)(t + 2) * kstep;
            const char* a3 = a2 + kstep; const char* b3 = b2 + kstep;
            PG8_LDB(B0, 0, 0); PG8_LDB(B1, 0, 1); PG8_SCHED; PG8_LDA(At, 0, 0); PG8_STAGE(PG8_SA(1, 1), a1 + hstepA, voffA);
            PG8_WAIT_V(8); PG8_WAIT_L(0); PG8_BAR; PG8_MMA(0, 0, At, B0); PG8_MMA(0, 1, At, B1); PG8_BAR; PG8_SCHED;
            PG8_LDA(At, 0, 1); PG8_STAGE(PG8_SB(0, 0), b2, voffB); PG8_STAGE(PG8_SB(0, 1), b2 + hstepB, voffB); PG8_STAGE(PG8_SA(0, 0), a2, voffA);
            PG8_WAIT_V(8); PG8_WAIT_L(0); PG8_BAR; PG8_MMA(1, 0, At, B0); PG8_MMA(1, 1, At, B1); PG8_BAR; PG8_SCHED;
            PG8_LDB(B0, 1, 0); PG8_LDB(B1, 1, 1); PG8_SCHED; PG8_LDA(At, 1, 0); PG8_STAGE(PG8_SA(0, 1), a2 + hstepA, voffA);
            PG8_WAIT_V(8); PG8_WAIT_L(0); PG8_BAR; PG8_MMA(0, 0, At, B0); PG8_MMA(0, 1, At, B1); PG8_BAR; PG8_SCHED;
            PG8_LDA(At, 1, 1); PG8_STAGE(PG8_SB(1, 0), b3, voffB); PG8_STAGE(PG8_SB(1, 1), b3 + hstepB, voffB); PG8_STAGE(PG8_SA(1, 0), a3, voffA);
            PG8_WAIT_V(8); PG8_WAIT_L(0); PG8_BAR; PG8_MMA(1, 0, At, B0); PG8_MMA(1, 1, At, B1); PG8_BAR; PG8_SCHED;
        }
        if (wr == 0) PG8_BAR;
        asm volatile("s_nop 15\n\ts_nop 15" ::: "memory");
        E(acc, cur, wr, wc, fr, fq);
        if (!has_next) break;
#pragma unroll
        for (int a = 0; a < 2; ++a)
#pragma unroll
            for (int b = 0; b < 2; ++b)
#pragma unroll
                for (int m = 0; m < 4; ++m)
#pragma unroll
                    for (int n = 0; n < 2; ++n) acc[a][b][m][n] = (f32x4){0.f, 0.f, 0.f, 0.f};
        cur = nxt; cA = nA; cB = nB; ++ui;
        if (wr == 1) PG8_BAR;
    }
    PG8_WAIT_V(0);
    PG8_BAR;
#undef PG8_APTR
#undef PG8_BPTR
#undef PG8_SA
#undef PG8_SB
#undef PG8_STAGE
#undef PG8_LDA
#undef PG8_LDB
#undef PG8_MMA
#undef PG8_WAIT_V
#undef PG8_WAIT_L
#undef PG8_BAR
#undef PG8_SCHED
}
}

struct Args {
    const float* x; const float* p; const float* pool_w; const float* pool_scale; const float* ssm_in_w; const float* conv_w; const float* conv_b;
    const float* dt_bias; const float* a_log; const float* d_skip; const float* norm_w; const float* out_w; const float* w1; const float* w2;
    const float* ln_g; const float* ln_b; const float* ple_w; const float* gate_w;
    float* out; unsigned char* ws;
};

typedef __attribute__((address_space(4))) const Args CArgs;
__device__ __forceinline__ CArgs* kargs() { CArgs* p = (CArgs*)__builtin_amdgcn_kernarg_segment_ptr(); asm volatile("" : "+s"(p)); return p; }
#define KA(f) (kargs()->f)

__device__ __forceinline__ void transpose_item(const float* __restrict__ W, int K, int N, bf16_t* __restrict__ WT, int row_off, LAS float* scr, int item, int lane,
                                               const float* __restrict__ gk, const float* __restrict__ bk, float* uo, float* vo) {
    const int nblk = N / 32, kb = item / nblk, nb = item % nblk, k0 = 64 * kb, n0 = 32 * nb, hi = lane >> 5;
    const float* src = W + (size_t)(k0 + hi) * N + n0 + (lane & 31);
    float w[32];
#pragma unroll
    for (int i = 0; i < 32; ++i) w[i] = src[(size_t)(2 * i) * N];
    if (gk) {
        const float gl = gk[k0 + lane], bl = bk ? bk[k0 + lane] : 0.f; float pu = 0.f, pv = 0.f;
#pragma unroll
        for (int i = 0; i < 32; ++i) { const float g0 = rdlane(gl, 2 * i), g1 = rdlane(gl, 2 * i + 1), b0 = rdlane(bl, 2 * i), b1 = rdlane(bl, 2 * i + 1);
            pv += w[i] * (hi ? b1 : b0); w[i] *= (hi ? g1 : g0); pu += bf_lo(cvt_pk_bf16(w[i], 0.f)); }
        if (uo) { pu += __shfl_xor(pu, 32); pv += __shfl_xor(pv, 32);
            atomicAdd((lane < 32 ? uo : vo) + n0 + (lane & 31), lane < 32 ? pu : pv); }
    }
#pragma unroll
    for (int i = 0; i < 32; ++i) scr[(2 * i + hi) * 33 + (lane & 31)] = w[i];
    LDS_WAIT();
    const int c = lane & 7;
#pragma unroll
    for (int j = 0; j < 4; ++j) { const int n = (lane >> 3) + 8 * j; const LAS float* sp = scr + (8 * c) * 33 + n;
        u32x4 o; o.x = cvt_pk_bf16(sp[0 * 33], sp[1 * 33]); o.y = cvt_pk_bf16(sp[2 * 33], sp[3 * 33]); o.z = cvt_pk_bf16(sp[4 * 33], sp[5 * 33]); o.w = cvt_pk_bf16(sp[6 * 33], sp[7 * 33]);
        *(u32x4*)(WT + (size_t)(row_off + n0 + n) * K + k0 + 8 * c) = o; }
    LDS_WAIT();
}
__device__ __forceinline__ void transpose_matrix(const float* W, int K, int N, bf16_t* WT, int row_off, LAS float* scr, int gw, int ngw, int lane,
                                                 const float* gk = nullptr, const float* bk = nullptr, float* uo = nullptr, float* vo = nullptr) {
    const int nitems = (K / 64) * (N / 32);
    for (int it = gw; it < nitems; it += ngw) transpose_item(W, K, N, WT, row_off, scr, it, lane, gk, bk, uo, vo);
}
__device__ __forceinline__ void cvt_rows(const float* src, bf16_t* dst, size_t n4, size_t gt, size_t ngt) {
    for (size_t i = gt; i < n4; i += ngt) { const f32x4 v = ((const f32x4*)src)[i]; u32x2 w; w.x = cvt_pk_bf16(v[0], v[1]); w.y = cvt_pk_bf16(v[2], v[3]); ((u32x2*)dst)[i] = w; }
}
template <int WIN> __device__ __forceinline__ void pool_item(const f32x4* __restrict__ xp, u32x2* __restrict__ op, int t0) {
    constexpr int NR = WIN - 1 + 16;
    f32x4 a[NR], orig[16];
#pragma unroll
    for (int i = 0; i < NR; ++i) { const int t = t0 - (WIN - 1) + i; a[i] = (t >= 0) ? xp[(size_t)t * 512] : (f32x4){0.f, 0.f, 0.f, 0.f}; }
#pragma unroll
    for (int r = 0; r < 16; ++r) orig[r] = a[WIN - 1 + r];
#pragma unroll
    for (int step = 1; step < WIN; step <<= 1)
#pragma unroll
        for (int i = NR - 1; i >= step; --i) a[i] += a[i - step];
#pragma unroll
    for (int r = 0; r < 16; ++r) { const int t = t0 + r; const float inv = 1.0f / (float)((t + 1) < WIN ? (t + 1) : WIN);
        const f32x4 o = a[WIN - 1 + r] * inv - orig[r];
        u32x2 w; w.x = cvt_pk_bf16(o[0], o[1]); w.y = cvt_pk_bf16(o[2], o[3]); op[(size_t)t * 512] = w; }
}
__device__ __forceinline__ void pool_phase(const float* x, bf16_t* PB, int gt, int ngt) {
    for (int it = gt; it < NB * 128 * 512; it += ngt) {
        const int c4 = it & 511, seg = (it >> 9) & 127, b = it >> 16, gi = __builtin_amdgcn_readfirstlane(c4 >> 7);
        const f32x4* xp = (const f32x4*)(x + (size_t)b * SEQL * DM) + c4;
        u32x2* op = (u32x2*)(PB + (size_t)b * SEQL * DM) + c4;
        if (gi == 0) pool_item<2>(xp, op, seg * 16); else if (gi == 1) pool_item<4>(xp, op, seg * 16); else if (gi == 2) pool_item<8>(xp, op, seg * 16); else pool_item<16>(xp, op, seg * 16);
    }
}

__device__ __forceinline__ void dt_phase(const bf16_t* X, const bf16_t* WT, const float* dt_bias, float* DTo, int row_lo, int ntask) {
    const int tid = launder((int)threadIdx.x), wid = __builtin_amdgcn_readfirstlane(tid >> 6), lane = tid & 63, fr = lane & 15, fq = lane >> 4;
    for (int task = blockIdx.x * 8 + wid; task < ntask; task += gridDim.x * 8) {
        const int r0 = row_lo + (task >> 1) * 16, n0 = (task & 1) * 32;
        const bf16_t* xa = X + (size_t)(r0 + fr) * DM + fq * 8;
        const bf16_t* wb = WT + (size_t)(ZXW + n0 + fr) * DM + fq * 8;
        f32x4 a0 = (f32x4){0.f, 0.f, 0.f, 0.f}, a1 = (f32x4){0.f, 0.f, 0.f, 0.f};
#pragma unroll 8
        for (int k = 0; k < DM; k += 32) {
            const bf16x8 xf = *(const bf16x8*)(xa + k), w0 = *(const bf16x8*)(wb + k), w1 = *(const bf16x8*)(wb + (size_t)16 * DM + k);
            a0 = __builtin_amdgcn_mfma_f32_16x16x32_bf16(w0, xf, a0, 0, 0, 0); a1 = __builtin_amdgcn_mfma_f32_16x16x32_bf16(w1, xf, a1, 0, 0, 0);
        }
        const f32x4 b0 = *(const f32x4*)(dt_bias + n0 + 4 * fq), b1 = *(const f32x4*)(dt_bias + n0 + 16 + 4 * fq);
        f32x4 v0 = a0 + b0, v1 = a1 + b1;
#pragma unroll
        for (int j = 0; j < 4; ++j) { v0[j] = v0[j] > 20.f ? v0[j] : log1pf(__expf(v0[j])); v1[j] = v1[j] > 20.f ? v1[j] : log1pf(__expf(v1[j])); }
        float* o = DTo + (size_t)(r0 + fr) * 64 + n0 + 4 * fq;
        *(f32x4*)o = v0; *(f32x4*)(o + 16) = v1;
    }
}

#define UNPK(dst, SRC_) do { dst[0] = bf_lo((SRC_).x); dst[1] = bf_hi((SRC_).x); dst[2] = bf_lo((SRC_).y); dst[3] = bf_hi((SRC_).y); dst[4] = bf_lo((SRC_).z); dst[5] = bf_hi((SRC_).z); dst[6] = bf_lo((SRC_).w); dst[7] = bf_hi((SRC_).w); } while (0)
__device__ __forceinline__ void conv_phase(bf16_t* zx, const bf16_t* HALO, const float* conv_w, const float* conv_b) {
    const int tid = launder((int)threadIdx.x), seg = tid >> 6, cgi = tid & 63;
    for (int item = blockIdx.x; item < 128 * 12; item += gridDim.x) {
        const int bc = item / 12, ch = (item % 12) * 512 + cgi * 8;
        bf16_t* base = zx + ((size_t)bc * CHUNKL + seg * 16) * ZXW + DIN + ch;
        u32x4 hal[3], raw[16];
#pragma unroll
        for (int r = 0; r < 3; ++r) {
            if (seg == 0) hal[r] = ((bc & 15) == 0) ? (u32x4){0u, 0u, 0u, 0u} : *(const u32x4*)(HALO + ((size_t)(bc - 1) * 3 + r) * CONVD + ch);
            else hal[r] = *(const u32x4*)(base + (ptrdiff_t)(r - 3) * ZXW);
        }
#pragma unroll
        for (int r = 0; r < 16; ++r) raw[r] = *(const u32x4*)(base + (size_t)r * ZXW);
        float cw[4][8], cb[8];
#pragma unroll
        for (int k = 0; k < 4; ++k) { const f32x4 w0 = *(const f32x4*)(conv_w + k * CONVD + ch), w1 = *(const f32x4*)(conv_w + k * CONVD + ch + 4);
#pragma unroll
            for (int i = 0; i < 4; ++i) { cw[k][i] = w0[i]; cw[k][4 + i] = w1[i]; } }
        { const f32x4 b0 = *(const f32x4*)(conv_b + ch), b1 = *(const f32x4*)(conv_b + ch + 4);
#pragma unroll
          for (int i = 0; i < 4; ++i) { cb[i] = b0[i]; cb[4 + i] = b1[i]; } }
        asm volatile("s_waitcnt vmcnt(0)" ::: "memory");
        __syncthreads();
        float u0[8], u1[8], u2[8];
        UNPK(u0, hal[0]); UNPK(u1, hal[1]); UNPK(u2, hal[2]);
#pragma unroll
        for (int r = 0; r < 16; ++r) {
            float cu[8], v[8]; UNPK(cu, raw[r]);
#pragma unroll
            for (int i = 0; i < 8; ++i) { const float a = cb[i] + cw[0][i] * u0[i] + cw[1][i] * u1[i] + cw[2][i] * u2[i] + cw[3][i] * cu[i]; v[i] = fast_silu(a); u0[i] = u1[i]; u1[i] = u2[i]; u2[i] = cu[i]; }
            u32x4 w; w.x = cvt_pk_bf16(v[0], v[1]); w.y = cvt_pk_bf16(v[2], v[3]); w.z = cvt_pk_bf16(v[4], v[5]); w.w = cvt_pk_bf16(v[6], v[7]);
            *(u32x4*)(base + (size_t)r * ZXW) = w;
        }
    }
}

constexpr int SST = 272;
constexpr int L_SC = 0, L_SB = 34816, L_SM = 69632, L_SXT = 104448, L_SST = 121856, L_SX = 139264, SXS = 144, L_ACS = 157696, L_SSD_END = 158208;
static_assert(L_SSD_END <= LDS_BYTES, "SSD LDS map");

__device__ __forceinline__ void ssd_phase(LAS unsigned char* lds, bf16_t* zx, const float* DTp, const float* a_log,
                                          const float* d_skip, const float* norm_w, float* ssq) {
    const int tid = launder((int)threadIdx.x), wid = __builtin_amdgcn_readfirstlane(tid >> 6), lane = tid & 63, fr = lane & 15, fq = lane >> 4;
    const int bx = blockIdx.x, xcd = bx & 7, slot = bx >> 3;
    LAS float* sAcs = (LAS float*)(lds + L_ACS);
    for (int round = 0; round < 2; ++round) {
        int b, h;
        if (gridDim.x == 256) { const int q = ((slot >> 3) + 4 * round) * 8 + xcd; b = q >> 3; h = (q & 7) * 8 + (slot & 7); }
        else { const int item = bx + round * (int)gridDim.x; if (item >= NB * NHEAD) break; b = item >> 6; h = item & 63; }
        const int g = h >> 3;
        const float a_h = -__expf(a_log[h]), d_h = d_skip[h];
        f32x4 st[4];
#pragma unroll
        for (int i = 0; i < 4; ++i) st[i] = (f32x4){0.f, 0.f, 0.f, 0.f};
        __syncthreads();
        for (int i = tid; i < 64 * SST / 4; i += 512) ((LAS unsigned*)(lds + L_SST))[i] = 0u;
        const bf16_t* xsrc = zx + ((size_t)b * SEQL) * ZXW + DIN;
        u32x4 pf[10]; float pdt[2], sdt[2];
#define SSD_PREFETCH(cc) do { \
        _Pragma("unroll") for (int i = 0; i < 2; ++i) { const int q = tid + 512 * i, l = q & 127, pc = q >> 7; \
            pf[i] = *(const u32x4*)(xsrc + (size_t)((cc) * CHUNKL + l) * ZXW + h * 64 + pc * 8); pdt[i] = DTp[((size_t)b * SEQL + (cc) * CHUNKL + l) * 64 + h]; } \
        _Pragma("unroll") for (int i = 2; i < 6; ++i) { const int q = tid + 512 * i - 1024, l = q >> 4, pc = q & 15; \
            pf[i] = *(const u32x4*)(xsrc + (size_t)((cc) * CHUNKL + l) * ZXW + DIN + g * 128 + pc * 8); } \
        _Pragma("unroll") for (int i = 6; i < 10; ++i) { const int q = tid + 512 * i - 3072, l = q >> 4, pc = q & 15; \
            pf[i] = *(const u32x4*)(xsrc + (size_t)((cc) * CHUNKL + l) * ZXW + DIN + NGRP * DSTATE + g * 128 + pc * 8); } \
        if (wid == 7) { const size_t r0 = (size_t)b * SEQL + (cc) * CHUNKL + 2 * lane; sdt[0] = DTp[r0 * 64 + h]; sdt[1] = DTp[(r0 + 1) * 64 + h]; } } while (0)
        SSD_PREFETCH(0);
        const int l0 = wid * 16, kbmax = wid >> 1;
        for (int c = 0; c < NCHUNK; ++c) {
            __syncthreads();
#pragma unroll
            for (int i = 0; i < 2; ++i) { const int q = tid + 512 * i, l = q & 127, pc = q >> 7;
                *(LAS u32x4*)(lds + L_SX + l * SXS + pc * 16) = pf[i];
                float v[8]; UNPK(v, pf[i]); const float d = pdt[i];
#pragma unroll
                for (int j = 0; j < 8; j += 2) { const unsigned pk = cvt_pk_bf16(v[j] * d, v[j + 1] * d);
                    *(LAS unsigned short*)(lds + L_SXT + (pc * 8 + j) * SST + l * 2) = (unsigned short)(pk & 0xffffu);
                    *(LAS unsigned short*)(lds + L_SXT + (pc * 8 + j + 1) * SST + l * 2) = (unsigned short)(pk >> 16); } }
#pragma unroll
            for (int i = 2; i < 6; ++i) { const int q = tid + 512 * i - 1024, l = q >> 4, pc = q & 15; *(LAS u32x4*)(lds + L_SB + l * SST + pc * 16) = pf[i]; }
#pragma unroll
            for (int i = 6; i < 10; ++i) { const int q = tid + 512 * i - 3072, l = q >> 4, pc = q & 15; *(LAS u32x4*)(lds + L_SC + l * SST + pc * 16) = pf[i]; }
            if (wid == 7) {
                const float da0 = sdt[0] * a_h, da1 = sdt[1] * a_h;
                float s = da0 + da1;
#pragma unroll
                for (int o = 1; o < 64; o <<= 1) { const float t = __shfl_up(s, o); if (lane >= o) s += t; }
                sAcs[2 * lane] = s - da1; sAcs[2 * lane + 1] = s;
            }
            __syncthreads();
            const int l = l0 + fr;
            const size_t row = (size_t)b * SEQL + c * CHUNKL + l;
            bf16_t* zp = zx + row * ZXW + h * 64 + 8 * fq;
            u32x4 zr[2];
#pragma unroll
            for (int a2 = 0; a2 < 2; ++a2) zr[a2] = *(const u32x4*)(zp + a2 * 32);
#define SSD_PR(pt) (32 * ((pt) >> 1) + 8 * (fr >> 2) + 4 * ((pt) & 1) + (fr & 3))
            if (c + 1 < NCHUNK) SSD_PREFETCH(c + 1);
            const float acs_end = sAcs[CHUNKL - 1];
#pragma unroll
            for (int i = 0; i < 4; ++i) { const int item = tid + 512 * i, ll = item & 127, ng = item >> 7;
                const float dec = __expf(acs_end - sAcs[ll]);
                const u32x4 w = *(const LAS u32x4*)(lds + L_SB + ll * SST + ng * 16);
                float v[8]; UNPK(v, w);
#pragma unroll
                for (int j = 0; j < 8; j += 2) { const unsigned pk = cvt_pk_bf16(v[j] * dec, v[j + 1] * dec);
                    *(LAS unsigned short*)(lds + L_SM + (ng * 8 + j) * SST + ll * 2) = (unsigned short)(pk & 0xffffu);
                    *(LAS unsigned short*)(lds + L_SM + (ng * 8 + j + 1) * SST + ll * 2) = (unsigned short)(pk >> 16); } }
            {
                bf16x8 yc[4];
#pragma unroll
                for (int kb = 0; kb < 4; ++kb) yc[kb] = *(const LAS bf16x8*)(lds + L_SC + (l0 + fr) * SST + kb * 64 + fq * 16);
                const float acs_l = sAcs[l];
                f32x4 yd[4], yo[4];
#pragma unroll
                for (int i = 0; i < 4; ++i) { yd[i] = (f32x4){0.f, 0.f, 0.f, 0.f}; yo[i] = (f32x4){0.f, 0.f, 0.f, 0.f}; }
                for (int kp = 0; kp <= kbmax; ++kp) {
                    const int t0 = 2 * kp, t1 = 2 * kp + 1; const bool do1 = (t1 <= wid);
                    bf16x8 xb0[4], xb1[4]; u32x2 x0[4], x1[4];
#pragma unroll
                    for (int kb = 0; kb < 4; ++kb) { xb0[kb] = *(const LAS bf16x8*)(lds + L_SB + (t0 * 16 + fr) * SST + kb * 64 + fq * 16);
                        xb1[kb] = *(const LAS bf16x8*)(lds + L_SB + (t1 * 16 + fr) * SST + kb * 64 + fq * 16); }
                    const f32x4 as0 = *(const LAS f32x4*)(lds + L_ACS + (t0 * 16 + 4 * fq) * 4), as1 = *(const LAS f32x4*)(lds + L_ACS + (t1 * 16 + 4 * fq) * 4);
                    f32x4 a0 = (f32x4){0.f, 0.f, 0.f, 0.f}, a1 = (f32x4){0.f, 0.f, 0.f, 0.f};
#pragma unroll
                    for (int kb = 0; kb < 4; ++kb) { a0 = __builtin_amdgcn_mfma_f32_16x16x32_bf16(xb0[kb], yc[kb], a0, 0, 0, 0); a1 = __builtin_amdgcn_mfma_f32_16x16x32_bf16(xb1[kb], yc[kb], a1, 0, 0, 0); }
#pragma unroll
                    for (int pt = 0; pt < 4; ++pt) { x0[pt] = *(const LAS u32x2*)(lds + L_SXT + SSD_PR(pt) * SST + (kp * 32 + 4 * fq) * 2);
                        x1[pt] = *(const LAS u32x2*)(lds + L_SXT + SSD_PR(pt) * SST + (kp * 32 + 16 + 4 * fq) * 2); }
#pragma unroll
                    for (int r = 0; r < 4; ++r) { const int s0 = t0 * 16 + 4 * fq + r, s1 = t1 * 16 + 4 * fq + r;
                        a0[r] = (s0 <= l) ? a0[r] * __expf(acs_l - as0[r]) : 0.f; a1[r] = (do1 && s1 <= l) ? a1[r] * __expf(acs_l - as1[r]) : 0.f; }
                    u32x4 mw; mw.x = cvt_pk_bf16(a0[0], a0[1]); mw.y = cvt_pk_bf16(a0[2], a0[3]); mw.z = cvt_pk_bf16(a1[0], a1[1]); mw.w = cvt_pk_bf16(a1[2], a1[3]);
                    asm volatile("s_nop 1" : "+v"(mw));
                    bf16x8 ym; __builtin_memcpy(&ym, &mw, 16);
#pragma unroll
                    for (int pt = 0; pt < 4; ++pt) { u32x4 xw; xw.x = x0[pt].x; xw.y = x0[pt].y; xw.z = x1[pt].x; xw.w = x1[pt].y;
                        bf16x8 xx; __builtin_memcpy(&xx, &xw, 16);
                        yd[pt] = __builtin_amdgcn_mfma_f32_16x16x32_bf16(xx, ym, yd[pt], 0, 0, 0); }
                }
#pragma unroll
                for (int kh = 0; kh < 2; ++kh) {
                    bf16x8 sfr[2][4];
#pragma unroll
                    for (int k2 = 0; k2 < 2; ++k2)
#pragma unroll
                        for (int pt = 0; pt < 4; ++pt) sfr[k2][pt] = *(const LAS bf16x8*)(lds + L_SST + SSD_PR(pt) * SST + (kh * 2 + k2) * 64 + fq * 16);
#pragma unroll
                    for (int k2 = 0; k2 < 2; ++k2)
#pragma unroll
                        for (int pt = 0; pt < 4; ++pt) yo[pt] = __builtin_amdgcn_mfma_f32_16x16x32_bf16(sfr[k2][pt], yc[kh * 2 + k2], yo[pt], 0, 0, 0);
                }
                const float el = __expf(acs_l);
                float sq = 0.f;
#pragma unroll
                for (int a2 = 0; a2 < 2; ++a2) {
                    const u32x4 xw = *(const LAS u32x4*)(lds + L_SX + l * SXS + (a2 * 32 + 8 * fq) * 2);
                    const u32x4 zw = zr[a2];
                    const f32x4 ya = yd[2 * a2] + yo[2 * a2] * el, yb = yd[2 * a2 + 1] + yo[2 * a2 + 1] * el;
                    float y0 = ya[0] + d_h * bf_lo(xw.x), y1 = ya[1] + d_h * bf_hi(xw.x), y2 = ya[2] + d_h * bf_lo(xw.y), y3 = ya[3] + d_h * bf_hi(xw.y);
                    float y4 = yb[0] + d_h * bf_lo(xw.z), y5 = yb[1] + d_h * bf_hi(xw.z), y6 = yb[2] + d_h * bf_lo(xw.w), y7 = yb[3] + d_h * bf_hi(xw.w);
                    y0 *= fast_silu(bf_lo(zw.x)); y1 *= fast_silu(bf_hi(zw.x)); y2 *= fast_silu(bf_lo(zw.y)); y3 *= fast_silu(bf_hi(zw.y));
                    y4 *= fast_silu(bf_lo(zw.z)); y5 *= fast_silu(bf_hi(zw.z)); y6 *= fast_silu(bf_lo(zw.w)); y7 *= fast_silu(bf_hi(zw.w));
                    sq += ((y0 * y0 + y1 * y1) + (y2 * y2 + y3 * y3)) + ((y4 * y4 + y5 * y5) + (y6 * y6 + y7 * y7));
                    u32x4 w; w.x = cvt_pk_bf16(y0, y1); w.y = cvt_pk_bf16(y2, y3); w.z = cvt_pk_bf16(y4, y5); w.w = cvt_pk_bf16(y6, y7);
                    *(u32x4*)(zp + a2 * 32) = w;
                }
                sq += __shfl_xor(sq, 16); sq += __shfl_xor(sq, 32);
                if (fq == 0) atomicAdd(ssq + row, sq);
            }
            __syncthreads();
            {
                const float ce = __expf(acs_end);
#pragma unroll
                for (int pt = 0; pt < 4; ++pt) st[pt] = st[pt] * ce;
#pragma unroll
                for (int kh = 0; kh < 2; ++kh) {
                    bf16x8 xb[2], yx[2][4];
#pragma unroll
                    for (int k2 = 0; k2 < 2; ++k2) { xb[k2] = *(const LAS bf16x8*)(lds + L_SM + (l0 + fr) * SST + (kh * 2 + k2) * 64 + fq * 16);
#pragma unroll
                        for (int pt = 0; pt < 4; ++pt) yx[k2][pt] = *(const LAS bf16x8*)(lds + L_SXT + (pt * 16 + fr) * SST + (kh * 2 + k2) * 64 + fq * 16); }
#pragma unroll
                    for (int k2 = 0; k2 < 2; ++k2)
#pragma unroll
                        for (int pt = 0; pt < 4; ++pt) st[pt] = __builtin_amdgcn_mfma_f32_16x16x32_bf16(xb[k2], yx[k2][pt], st[pt], 0, 0, 0);
                }
                asm volatile("s_nop 15\n\ts_nop 15" : "+v"(st[0]), "+v"(st[1]), "+v"(st[2]), "+v"(st[3]));
#pragma unroll
                for (int pt = 0; pt < 4; ++pt) { u32x2 w; w.x = cvt_pk_bf16(st[pt][0], st[pt][1]); w.y = cvt_pk_bf16(st[pt][2], st[pt][3]);
                    *(LAS u32x2*)(lds + L_SST + (pt * 16 + fr) * SST + (l0 + 4 * fq) * 2) = w; }
            }
        }
#undef SSD_PREFETCH
#undef SSD_PR
    }
    __syncthreads();
}

__global__ void __launch_bounds__(512, 2) fwd_megakernel(Args a) {
    extern __shared__ __attribute__((aligned(16))) unsigned char lds_raw[];
    LAS unsigned char* lds = (LAS unsigned char*)lds_raw;
    cg::grid_group grid = cg::this_grid();
    const int G = gridDim.x;
    volatile LAS unsigned* barst = (volatile LAS unsigned*)(lds + L_BARST);
    if (threadIdx.x < 2) barst[threadIdx.x] = 0u;
    __syncthreads();
    xcd_barrier_post((unsigned*)(KA(ws) + WS_BAR));
    if (gridDim.x == 0x7fffffffu) grid.sync();
#define GRID_SYNC() xcd_barrier((unsigned*)(KA(ws) + WS_BAR), barst)
#define SSQ ((float*)(KA(ws) + WS_SSQ))
#define W1t ((bf16_t*)(KA(ws) + WS_W + W_W1))
#define W2t ((bf16_t*)(KA(ws) + WS_W + W_W2))
#define WGt ((bf16_t*)(KA(ws) + WS_W + W_GATE))
#define WPt ((bf16_t*)(KA(ws) + WS_W + W_PLE))
#define WAt ((bf16_t*)(KA(ws) + WS_W + W_A))
#define WOt ((bf16_t*)(KA(ws) + WS_W + W_OUT))
#define XB ((bf16_t*)(KA(ws) + WS_XB))
#define PBF ((bf16_t*)(KA(ws) + WS_PBF))
#define DT ((float*)(KA(ws) + WS_DT))
#define BIG ((bf16_t*)(KA(ws) + WS_BIG))
#define PW ((bf16_t*)(KA(ws) + WS_BIG + BIG_PW))
#define XF (KA(out))
#define XB1 ((bf16_t*)KA(out))
#define HALOB ((bf16_t*)(KA(ws) + WS_HALO))

#define ST1 ((float*)(KA(ws) + WS_ST1))
#define ST2 ((float*)(KA(ws) + WS_ST2))
#define UVP(layer, off) ((float*)(KA(ws) + WS_UV) + (layer) * UV_LAYER + (off))
    {
        const int tid = launder((int)threadIdx.x), gt = blockIdx.x * 512 + tid, ngt = launder_s(G) * 512;
        pool_phase(KA(x), BIG, gt, ngt);
        cvt_rows(KA(p), PBF, (size_t)2 * MROWS * PLED / 4, gt, ngt);
    }
#define PREPASS_VARS() const int tid = launder((int)threadIdx.x), lane = tid & 63, wave = __builtin_amdgcn_readfirstlane(tid >> 6); \
        const int gw = blockIdx.x * 8 + wave, gt = blockIdx.x * 512 + tid, ngw = launder_s(G) * 8, ngt = launder_s(G) * 512; \
        LAS float* scr = (LAS float*)(lds + wave * 16384); (void)gt; (void)ngt
#define PREPASS_MAIN(L) do { PREPASS_VARS(); \
        transpose_matrix(KA(w1) + (size_t)(L) * DM * DFF, DM, DFF, W1t, 0, scr, gw, ngw, lane, \
                         KA(ln_g) + (size_t)((L) * 2 + 0) * DM, KA(ln_b) + (size_t)((L) * 2 + 0) * DM, UVP((L), UV_U1), UVP((L), UV_V1)); \
        transpose_matrix(KA(w2) + (size_t)(L) * DFF * DM, DFF, DM, W2t, 0, scr, gw, ngw, lane); \
        if ((L) == 0) { for (int gi = 0; gi < 4; ++gi) transpose_matrix(KA(pool_w) + (size_t)gi * 512 * 512, 512, 512, WAt, gi * 512, scr, gw, ngw, lane); } \
        else { transpose_matrix(KA(ssm_in_w), DM, NIN, WAt, 0, scr, gw, ngw, lane); \
               transpose_matrix(KA(out_w), DIN, DM, WOt, 0, scr, gw, ngw, lane, KA(norm_w)); } } while (0)
#define PREPASS_LATE(L) do { PREPASS_VARS(); \
        transpose_matrix(KA(gate_w) + (size_t)(L) * DM * DM, DM, DM, WGt, 0, scr, gw, ngw, lane, \
                         KA(ln_g) + (size_t)((L) * 2 + 1) * DM, KA(ln_b) + (size_t)((L) * 2 + 1) * DM, UVP((L), UV_UG), UVP((L), UV_VG)); \
        transpose_matrix(KA(ple_w) + (size_t)(L) * PLED * DM, PLED, DM, WPt, 0, scr, gw, ngw, lane); \
        if ((L) == 1) { float* const zp = ST1; for (int i = gt; i < 4 * MROWS; i += ngt) zp[i] = 0.f; } } while (0)
    PREPASS_MAIN(0);
    PREPASS_LATE(0);
    GRID_SYNC();
    for (int layer = 0; layer < 2; ++layer) {
        if (layer == 0) {
            pg8::Gemm g{BIG, WAt, DM, 512, 512, 2, 512}; pg8::StaticOrder S; S.init(MROWS, DM, launder_s(G), launder_s((int)blockIdx.x));
            pg8::EpiRes<0> E{XF, XB, KA(x), KA(pool_scale), nullptr, nullptr, nullptr, ST1, nullptr, nullptr, nullptr, nullptr, XB, 0};
            pg8::gemm_phase(lds, g, S, E);
            GRID_SYNC();
        } else {
            PREPASS_LATE(1);
            __syncthreads();
            { pg8::Gemm g{XB1, WAt, DM, DM, DM, 1 << 20, 0}; pg8::StaticOrder S; S.init(MROWS, ZXW, launder_s(G), launder_s((int)blockIdx.x));
              pg8::EpiInProj E{BIG, DT, KA(dt_bias), HALOB};
              pg8::gemm_phase(lds, g, S, E); }
            GRID_SYNC();
            dt_phase(XB1, WAt, KA(dt_bias), DT, 0, 2 * (MROWS / 16));
            conv_phase(BIG, HALOB, KA(conv_w), KA(conv_b));
            GRID_SYNC();
            ssd_phase(lds, BIG, DT, KA(a_log), KA(d_skip), KA(norm_w), SSQ);
            GRID_SYNC();
            { pg8::Gemm g{BIG, WOt, ZXW, DIN, DIN, 1 << 20, 0}; pg8::StaticOrder S; S.init(MROWS, DM, launder_s(G), launder_s((int)blockIdx.x));
              pg8::EpiRes<2> E{XF, XB, nullptr, nullptr, SSQ, nullptr, nullptr, ST1, nullptr, nullptr, nullptr, nullptr, XB1, 0};
              pg8::gemm_phase(lds, g, S, E); }
            GRID_SYNC();
        }
        for (int step = 0; step < 3; ++step) {
            if (step > 0) {
                const int pmh = (step - 1) * (MROWS / 512);
                pg8::Gemm g{BIG, W2t, DFF, DFF, DFF, 1 << 20, 0}; pg8::StaticOrder S; S.init(MROWS / 2, DM, launder_s(G), launder_s((int)blockIdx.x), pmh);
                pg8::EpiRes<1> E{XF, XB, nullptr, nullptr, nullptr, nullptr, ST1, ST2, KA(ln_g) + (size_t)(layer * 2 + 0) * DM, KA(ln_b) + (size_t)(layer * 2 + 0) * DM, nullptr, nullptr, XB, 0};
                pg8::gemm_phase(lds, g, S, E);
            }
            if (step < 2) {
                const int pmh = step * (MROWS / 512);
                pg8::Gemm g{XB, W1t, DM, DM, DM, 1 << 20, 0}; pg8::StaticOrder S; S.init(MROWS / 2, DFF, launder_s(G), launder_s((int)blockIdx.x), pmh);
                pg8::EpiUp E{BIG, ST1, UVP(layer, UV_U1), UVP(layer, UV_V1)};
                pg8::gemm_phase(lds, g, S, E);
            }
            GRID_SYNC();
        }
        { pg8::Gemm g{PBF + (size_t)layer * MROWS * PLED, WPt, PLED, PLED, PLED, 1 << 20, 0}; pg8::StaticOrder S; S.init(MROWS, DM, launder_s(G), launder_s((int)blockIdx.x));
          pg8::EpiBf16<0> E{PW, DM};
          pg8::gemm_phase(lds, g, S, E); }
        { pg8::Gemm g{XB, WGt, DM, DM, DM, 1 << 20, 0}; pg8::StaticOrder S; S.init(MROWS, DM, launder_s(G), launder_s((int)blockIdx.x));
          pg8::EpiRes<3> E{XF, layer == 0 ? XB1 : XB, nullptr, nullptr, nullptr, PW, ST2, nullptr, KA(ln_g) + (size_t)(layer * 2 + 1) * DM, KA(ln_b) + (size_t)(layer * 2 + 1) * DM, UVP(layer, UV_UG), UVP(layer, UV_VG), XB, layer == 0 ? 1 : 0};
          pg8::gemm_phase(lds, g, S, E); }
        if (layer == 0) { PREPASS_MAIN(1); GRID_SYNC(); }
    }
}

extern "C" void kernel_launch(void* const* d_in, const int* in_sizes, int n_in, void* d_out, int out_size, void* d_ws, size_t ws_size, hipStream_t stream) {
    static int grid = 0;
    if (grid == 0) {
        if (n_in != 18 || in_sizes[0] != MROWS * DM || out_size != MROWS * DM || ws_size < WS_END) {
            fprintf(stderr, "kernel_launch: unexpected shapes (n_in %d, in0 %d, out %d, ws %zu, need %zu); nothing launched\n", n_in, n_in > 0 ? in_sizes[0] : -1, out_size, ws_size, (size_t)WS_END);
            grid = -1; return; }
        int dev = 0, cus = 0, per_cu = 0;
        if (hipGetDevice(&dev) != hipSuccess || hipDeviceGetAttribute(&cus, hipDeviceAttributeMultiprocessorCount, dev) != hipSuccess) { grid = -1; return; }
        if (hipFuncSetAttribute((const void*)fwd_megakernel, hipFuncAttributeMaxDynamicSharedMemorySize, LDS_BYTES) != hipSuccess) { fprintf(stderr, "kernel_launch: hipFuncSetAttribute failed\n"); grid = -1; return; }
        if (hipOccupancyMaxActiveBlocksPerMultiprocessor(&per_cu, (const void*)fwd_megakernel, 512, LDS_BYTES) != hipSuccess || per_cu < 1) { fprintf(stderr, "kernel_launch: occupancy query says %d blocks per CU\n", per_cu); per_cu = 1; }
        (void)hipGetLastError();
        grid = cus;
    }
    if (grid < 0) return;
    Args a{};
    a.x = (const float*)d_in[0]; a.p = (const float*)d_in[1]; a.pool_w = (const float*)d_in[2]; a.pool_scale = (const float*)d_in[3]; a.ssm_in_w = (const float*)d_in[4];
    a.conv_w = (const float*)d_in[5]; a.conv_b = (const float*)d_in[6]; a.dt_bias = (const float*)d_in[7]; a.a_log = (const float*)d_in[8]; a.d_skip = (const float*)d_in[9];
    a.norm_w = (const float*)d_in[10]; a.out_w = (const float*)d_in[11]; a.w1 = (const float*)d_in[12]; a.w2 = (const float*)d_in[13]; a.ln_g = (const float*)d_in[14];
    a.ln_b = (const float*)d_in[15]; a.ple_w = (const float*)d_in[16]; a.gate_w = (const float*)d_in[17];
    a.out = (float*)d_out; a.ws = (unsigned char*)d_ws;
    if (hipMemsetAsync(d_ws, 0, WS_W, stream) != hipSuccess) { fprintf(stderr, "kernel_launch: hipMemsetAsync failed\n"); return; }
    void* args[] = {&a};
    const hipError_t e = hipLaunchCooperativeKernel((const void*)fwd_megakernel, dim3(grid), dim3(512), args, LDS_BYTES, stream);
    if (e != hipSuccess) fprintf(stderr, "kernel_launch: cooperative launch failed: %s (grid %d)\n", hipGetErrorString(e), grid);
}
```

```cpp
#include <hip/hip_runtime.h>
#include <hip/hip_cooperative_groups.h>
#include <cstdio>
#include <cstdint>
namespace cg = cooperative_groups;

#define LAS __attribute__((address_space(3)))
typedef unsigned short bf16_t;
typedef short bf16x8 __attribute__((ext_vector_type(8)));
typedef float f32x4 __attribute__((ext_vector_type(4)));
typedef float f32x2 __attribute__((ext_vector_type(2)));
typedef unsigned u32x4 __attribute__((ext_vector_type(4)));
typedef unsigned u32x2 __attribute__((ext_vector_type(2)));

constexpr int MROWS = 16384, DM = 2048, DFF = 8192, DIN = 4096, ZXW = 10240, NINP = 10496, NIN = 10304, SEQL = 2048, NB = 8, PLED = 256;
constexpr int NHEAD = 64, HDIM = 64, NGRP = 8, DSTATE = 128, CONVD = 6144, CHUNKL = 128, NCHUNK = 16;
constexpr float ALPHA_F = 1.41421356237309515f;
constexpr float LN_EPS_F = 1e-5f, RMS_EPS_F = 1e-5f;

constexpr size_t MiB = 1024 * 1024;
constexpr size_t WS_SSQ = 0;
constexpr size_t WS_BAR = 131072;
constexpr size_t WS_ST1 = 262144, WS_ST2 = 393216;
constexpr size_t WS_UV = 524288;
constexpr int UV_LAYER = 20480, UV_U1 = 0, UV_V1 = 8192, UV_UG = 16384, UV_VG = 18432;
constexpr size_t WS_W = 1 * MiB;
constexpr size_t W_W1 = 0, W_W2 = 33554432, W_GATE = 67108864, W_PLE = 75497472, W_A = 76546048, W_OUT = 119537664, W_END = 136314880;
constexpr size_t WS_XB = WS_W + W_END;
constexpr size_t WS_PBF = WS_XB + 67108864;
constexpr size_t WS_DT = WS_PBF + 16777216;
constexpr size_t WS_BIG = WS_DT + 4194304;
constexpr size_t BIG_PW = 268435456;
constexpr size_t WS_HALO = WS_BIG + 335544320;
constexpr size_t WS_END = WS_HALO + (size_t)128 * 3 * 6144 * 2;

constexpr int LDS_BYTES = 163840, L_BARST = 163824;

typedef __bf16 bf16x2_t __attribute__((ext_vector_type(2)));
__device__ __forceinline__ unsigned cvt_pk_bf16(float lo, float hi) { const f32x2 v = {lo, hi}; const bf16x2_t b = __builtin_convertvector(v, bf16x2_t); unsigned r; __builtin_memcpy(&r, &b, 4); return r; }
__device__ __forceinline__ float bf_lo(unsigned w) { return __uint_as_float(w << 16); }
__device__ __forceinline__ float bf_hi(unsigned w) { return __uint_as_float(w & 0xffff0000u); }
__device__ __forceinline__ float wave_sum(float v) {
#pragma unroll
    for (int o = 1; o < 64; o <<= 1) v += __shfl_xor(v, o);
    return v;
}
__device__ __forceinline__ float rdlane(float v, int l) { return __int_as_float(__builtin_amdgcn_readlane(__float_as_int(v), l)); }
__device__ __forceinline__ float fast_sigmoid(float v) { return __builtin_amdgcn_rcpf(1.0f + __expf(-v)); }
__device__ __forceinline__ float fast_silu(float v) { return v * fast_sigmoid(v); }
#define LDS_WAIT() asm volatile("s_waitcnt lgkmcnt(0)" ::: "memory")
__device__ __forceinline__ int launder_s(int v) { asm volatile("" : "+s"(v)); return v; }
__device__ __forceinline__ int launder(int v) { asm volatile("" : "+v"(v)); return v; }


#define XB_TMO      128
#define XB_XCNT(j)  (256  + 64 * (j))
#define XB_XSUB(j)  (1280 + 64 * (j))
#define XB_XGEN(j)  (2304 + 64 * (j))
#define XB_TOP      3328
#define XB_TOPGEN   3392
#define XCD_BAR_WORDS 3456
#define XB_SPIN_CAP (1u << 20)
__device__ __forceinline__ unsigned xb_ld(unsigned* p)              { return __hip_atomic_load(p, __ATOMIC_RELAXED, __HIP_MEMORY_SCOPE_AGENT); }
__device__ __forceinline__ unsigned xb_add(unsigned* p, unsigned v) { return __hip_atomic_fetch_add(p, v, __ATOMIC_RELAXED, __HIP_MEMORY_SCOPE_AGENT); }
__device__ __forceinline__ unsigned xb_xcc_id() { return (unsigned)__builtin_amdgcn_s_getreg((3 << 11) | 20) & 0xFu; }
#define XB_SPIN(cond, bar) do { unsigned _sp = 0; while (cond) { __builtin_amdgcn_s_sleep(1); \
    if ((++_sp & 255u) == 0u) { if (xb_ld(&(bar)[XB_TMO])) break; if (_sp > XB_SPIN_CAP) { atomicAdd(&(bar)[XB_TMO], 1u); break; } } } } while (0)
__device__ __forceinline__ void xcd_barrier_post(unsigned* bar) { if (threadIdx.x == 0) (void)xb_add(&bar[XB_XCNT(xb_xcc_id())], 1u); }
__device__ __forceinline__ void xcd_barrier_complete(unsigned* bar, unsigned x, unsigned& nloc, unsigned& nx) {
    const unsigned G = gridDim.x;
    unsigned sum, cnt, mine, sp = 0u;
    for (;;) {
        sum = 0u; cnt = 0u; mine = 0u;
#pragma unroll
        for (unsigned j = 0; j < 16; ++j) { const unsigned c = xb_ld(&bar[XB_XCNT(j)]); sum += c; cnt += (c > 0u) ? 1u : 0u; mine = (j == x) ? c : mine; }
        if (sum == G) break;
        __builtin_amdgcn_s_sleep(1);
        if ((++sp & 255u) == 0u) { if (xb_ld(&bar[XB_TMO])) break; if (sp > XB_SPIN_CAP) { atomicAdd(&bar[XB_TMO], 1u); break; } }
    }
    nloc = mine > 0u ? mine : 1u; nx = cnt > 0u ? cnt : 1u;
}
__device__ __forceinline__ void xcd_barrier(unsigned* bar, volatile LAS unsigned* st) {
    asm volatile("s_waitcnt vmcnt(0)" ::: "memory");
    __syncthreads();
    if (threadIdx.x == 0) {
        __builtin_amdgcn_s_waitcnt(0);
        const unsigned x = xb_xcc_id();
        unsigned nloc = st[0], nx = st[1];
        if (nloc == 0u) { xcd_barrier_complete(bar, x, nloc, nx); st[0] = nloc; st[1] = nx; }
        const unsigned old = xb_add(&bar[XB_XSUB(x)], 1u);
        const unsigned gen = old / nloc;
        if (old + 1u == (gen + 1u) * nloc) {
            __builtin_amdgcn_fence(__ATOMIC_RELEASE, "agent");
            asm volatile("s_waitcnt vmcnt(0)" ::: "memory");
            const unsigned og = xb_add(&bar[XB_TOP], 1u);
            const unsigned tg = og / nx;
            if (og + 1u == (tg + 1u) * nx) xb_add(&bar[XB_TOPGEN], 1u);
            else XB_SPIN(xb_ld(&bar[XB_TOPGEN]) == tg, bar);
            __builtin_amdgcn_fence(__ATOMIC_ACQUIRE, "agent");
            xb_add(&bar[XB_XGEN(x)], 1u);
            asm volatile("s_waitcnt vmcnt(0)" ::: "memory");
        } else {
            XB_SPIN(xb_ld(&bar[XB_XGEN(x)]) == gen, bar);
            __builtin_amdgcn_fence(__ATOMIC_ACQUIRE, "agent");
            asm volatile("s_waitcnt vmcnt(0)" ::: "memory");
        }
    }
    __syncthreads();
}

namespace pg8 {
constexpr int BM = 256, BK = 64, HALF = 128, HTB = HALF * BK * 2, STAGE_BYTES = 8 * HTB, NXCD = 8, WGM = 8;
__host__ __device__ __forceinline__ int lds_byte(int r, int c) { const int st = (r >> 4) * 2 + (c >> 5), rr = r & 15, cc = c & 31, ob = rr * 64 + cc * 2; return st * 1024 + (ob ^ (((ob >> 9) & 1) << 5)); }
__host__ __device__ __forceinline__ void stage_rc(int b, int& R, int& C) { const int st = b / 1024, sb = b % 1024, swz = sb ^ (((sb >> 9) & 1) << 5); R = (st >> 1) * 16 + swz / 64; C = (st & 1) * 32 + (swz % 64) / 2; }
__host__ __device__ __forceinline__ int perm32(int rho) { const int n = rho >> 4, i = rho & 15; return 8 * (i >> 2) + 4 * n + (i & 3); }

struct Unit { int pm, pn; };
struct Gemm { const bf16_t* A; const bf16_t* Bt; int lda, ldb, K, tpg, goff; };

struct StaticOrder {
    int nM, nN, nwg, G, c, pm0;
    __device__ void init(int M, int N, int G_, int c_, int pm0_ = 0) { nM = M / BM; nN = N / BM; nwg = nM * nN; G = G_; c = c_; pm0 = pm0_; }
    __device__ bool next(int i, Unit& u) const {
        const long L = (long)i * G + c; if (L >= nwg) return false;
        int wgid = (int)L; { const int q = nwg / NXCD, r = nwg % NXCD, xcd = wgid % NXCD, off = wgid / NXCD; wgid = (xcd < r ? xcd * (q + 1) : r * (q + 1) + (xcd - r) * q) + off; }
        const int nig = WGM * nN, gid = wgid / nig, fm = gid * WGM, gsz = (nM - fm) < WGM ? (nM - fm) : WGM;
        u.pm = pm0 + fm + ((wgid % nig) % gsz); u.pn = (wgid % nig) / gsz; return true;
    }
};

template <int ACT  > struct EpiBf16 {
    static constexpr bool PERM = true;
    bf16_t* O; int ldc;
    __device__ __forceinline__ void operator()(const f32x4 (&acc)[2][2][4][2], const Unit& u, int wr, int wc, int fr, int fq) const {
        const int row0 = u.pm * BM + wr * 64 + fr, col0 = u.pn * BM + wc * 32 + 8 * fq;
#pragma unroll
        for (int ai = 0; ai < 2; ++ai)
#pragma unroll
            for (int m = 0; m < 4; ++m) { bf16_t* rowp = O + (size_t)(row0 + ai * HALF + m * 16) * ldc + col0;
#pragma unroll
                for (int bj = 0; bj < 2; ++bj) { f32x4 v0 = acc[ai][bj][m][0], v1 = acc[ai][bj][m][1];
                    if (ACT == 1) {
#pragma unroll
                        for (int j = 0; j < 4; ++j) { const float a = fmaxf(v0[j], 0.f), b = fmaxf(v1[j], 0.f); v0[j] = a * a; v1[j] = b * b; }
                        asm volatile("" : "+v"(v0), "+v"(v1)); }
                    u32x4 w; w.x = cvt_pk_bf16(v0[0], v0[1]); w.y = cvt_pk_bf16(v0[2], v0[3]); w.z = cvt_pk_bf16(v1[0], v1[1]); w.w = cvt_pk_bf16(v1[2], v1[3]);
                    *(u32x4*)(rowp + bj * HALF) = w; }
                asm volatile("" ::: "memory"); }
    }
};
struct EpiInProj {
    static constexpr bool PERM = true;
    bf16_t* O; float* DT; const float* dt_bias; bf16_t* HALO;
    __device__ __forceinline__ void operator()(const f32x4 (&acc)[2][2][4][2], const Unit& u, int wr, int wc, int fr, int fq) const {
        const int row0 = u.pm * BM + wr * 64 + fr;
        if (u.pn < 40) {
            const int col0 = u.pn * BM + wc * 32 + 8 * fq;
            const bool halo_lane = (u.pn >= 16) && (wr == 1) && (fr >= 13);
#pragma unroll
            for (int ai = 0; ai < 2; ++ai)
#pragma unroll
                for (int m = 0; m < 4; ++m) { const int row = row0 + ai * HALF + m * 16; bf16_t* rowp = O + (size_t)row * ZXW + col0;
#pragma unroll
                    for (int bj = 0; bj < 2; ++bj) { const f32x4 v0 = acc[ai][bj][m][0], v1 = acc[ai][bj][m][1];
                        u32x4 w; w.x = cvt_pk_bf16(v0[0], v0[1]); w.y = cvt_pk_bf16(v0[2], v0[3]); w.z = cvt_pk_bf16(v1[0], v1[1]); w.w = cvt_pk_bf16(v1[2], v1[3]);
                        *(u32x4*)(rowp + bj * HALF) = w;
                        if (m == 3 && halo_lane) *(u32x4*)(HALO + ((size_t)(row >> 7) * 3 + (fr - 13)) * CONVD + (col0 + bj * HALF - DIN)) = w; } }
        } else if (wc < 2) {
            const int c0 = wc * 32 + 8 * fq;
            const f32x4 b0 = *(const f32x4*)(dt_bias + c0), b1 = *(const f32x4*)(dt_bias + c0 + 4);
#pragma unroll
            for (int ai = 0; ai < 2; ++ai)
#pragma unroll
                for (int m = 0; m < 4; ++m) { float* rowp = DT + (size_t)(row0 + ai * HALF + m * 16) * 64 + c0;
                    f32x4 v0 = acc[ai][0][m][0] + b0, v1 = acc[ai][0][m][1] + b1;
#pragma unroll
                    for (int j = 0; j < 4; ++j) { v0[j] = v0[j] > 20.f ? v0[j] : log1pf(__expf(v0[j])); v1[j] = v1[j] > 20.f ? v1[j] : log1pf(__expf(v1[j])); }
                    *(f32x4*)rowp = v0; *(f32x4*)(rowp + 4) = v1; }
        }
    }
};
__device__ __forceinline__ void ln_row_stats(const float* st, int row, float& mu, float& rstd) {
    const f32x2 sv = *(const f32x2*)(st + 2 * (size_t)row); mu = sv[0] * (1.0f / DM); const float var = sv[1] * (1.0f / DM) - mu * mu; rstd = __builtin_amdgcn_rsqf(fmaxf(var, 0.f) + LN_EPS_F);
}
template <int MODE> struct EpiRes {
    static constexpr bool PERM = true;
    float* XFp; bf16_t* XBo; const float* xin; const float* scale; const float* ssq; const bf16_t* PWp;
    const float* st_in; float* st_out; const float* lg; const float* lb; const float* uu; const float* vv;
    const bf16_t* XBi; int out_bf16;
    __device__ __forceinline__ void operator()(const f32x4 (&acc)[2][2][4][2], const Unit& u, int wr, int wc, int fr, int fq) const {
        const int row0 = u.pm * BM + wr * 64 + fr, col0 = u.pn * BM + wc * 32 + 8 * fq;
        float mu[8], rstd[8], s1[8], s2[8];
#pragma unroll
        for (int i = 0; i < 8; ++i) { const int row = row0 + (i >> 2) * HALF + (i & 3) * 16; mu[i] = 0.f; rstd[i] = 1.f; s1[i] = 0.f; s2[i] = 0.f;
            if (MODE == 1 || MODE == 3) ln_row_stats(st_in, row, mu[i], rstd[i]);
            if (MODE == 2) rstd[i] = __builtin_amdgcn_rsqf(ssq[row] * (1.0f / DIN) + RMS_EPS_F); }
#pragma unroll
        for (int bj = 0; bj < 2; ++bj) { const int cc = col0 + bj * HALF;
            f32x4 g0, g1, b0, b1, u0, u1, v0, v1;
            if (MODE == 0) { g0 = *(const f32x4*)(scale + cc); g1 = *(const f32x4*)(scale + cc + 4); }
            if (MODE == 1 || MODE == 3) { g0 = *(const f32x4*)(lg + cc); g1 = *(const f32x4*)(lg + cc + 4); b0 = *(const f32x4*)(lb + cc); b1 = *(const f32x4*)(lb + cc + 4); }
            if (MODE == 3) { u0 = *(const f32x4*)(uu + cc); u1 = *(const f32x4*)(uu + cc + 4); v0 = *(const f32x4*)(vv + cc); v1 = *(const f32x4*)(vv + cc + 4); }
#pragma unroll
            for (int i = 0; i < 8; ++i) { const int ai = i >> 2, m = i & 3; const size_t o = (size_t)(row0 + ai * HALF + m * 16) * DM + cc;
                const f32x4 a0 = acc[ai][bj][m][0], a1 = acc[ai][bj][m][1]; f32x4 r0, r1, t0, t1;
                if (MODE == 0) { t0 = *(const f32x4*)(xin + o); t1 = *(const f32x4*)(xin + o + 4); r0 = t0 * ALPHA_F + a0 * g0; r1 = t1 * ALPHA_F + a1 * g1; }
                if (MODE != 0) { const u32x4 tw = *(const u32x4*)(XBi + o);
                    t0 = (f32x4){bf_lo(tw.x), bf_hi(tw.x), bf_lo(tw.y), bf_hi(tw.y)}; t1 = (f32x4){bf_lo(tw.z), bf_hi(tw.z), bf_lo(tw.w), bf_hi(tw.w)}; }
                if (MODE == 1) { r0 = ((t0 - mu[i]) * rstd[i] * g0 + b0) * ALPHA_F + a0; r1 = ((t1 - mu[i]) * rstd[i] * g1 + b1) * ALPHA_F + a1; }
                if (MODE == 2) { r0 = t0 * ALPHA_F + a0 * rstd[i]; r1 = t1 * ALPHA_F + a1 * rstd[i]; }
                if (MODE == 3) { const u32x4 pw = *(const u32x4*)(PWp + o);
                    const f32x4 x0 = (t0 - mu[i]) * rstd[i] * g0 + b0, x1 = (t1 - mu[i]) * rstd[i] * g1 + b1;
                    const f32x4 p0 = (a0 - u0 * mu[i]) * rstd[i] + v0, p1 = (a1 - u1 * mu[i]) * rstd[i] + v1;
                    r0[0] = x0[0] + fast_sigmoid(p0[0]) * bf_lo(pw.x); r0[1] = x0[1] + fast_sigmoid(p0[1]) * bf_hi(pw.x); r0[2] = x0[2] + fast_sigmoid(p0[2]) * bf_lo(pw.y); r0[3] = x0[3] + fast_sigmoid(p0[3]) * bf_hi(pw.y);
                    r1[0] = x1[0] + fast_sigmoid(p1[0]) * bf_lo(pw.z); r1[1] = x1[1] + fast_sigmoid(p1[1]) * bf_hi(pw.z); r1[2] = x1[2] + fast_sigmoid(p1[2]) * bf_lo(pw.w); r1[3] = x1[3] + fast_sigmoid(p1[3]) * bf_hi(pw.w);
                    if (out_bf16) { u32x4 w; w.x = cvt_pk_bf16(r0[0], r0[1]); w.y = cvt_pk_bf16(r0[2], r0[3]); w.z = cvt_pk_bf16(r1[0], r1[1]); w.w = cvt_pk_bf16(r1[2], r1[3]); *(u32x4*)(XBo + o) = w; }
                    else { *(f32x4*)(XFp + o) = r0; *(f32x4*)(XFp + o + 4) = r1; } }
                if (MODE != 3) { u32x4 w; w.x = cvt_pk_bf16(r0[0], r0[1]); w.y = cvt_pk_bf16(r0[2], r0[3]); w.z = cvt_pk_bf16(r1[0], r1[1]); w.w = cvt_pk_bf16(r1[2], r1[3]);
                    *(u32x4*)(XBo + o) = w;
                    const float q0 = bf_lo(w.x), q1 = bf_hi(w.x), q2 = bf_lo(w.y), q3 = bf_hi(w.y), q4 = bf_lo(w.z), q5 = bf_hi(w.z), q6 = bf_lo(w.w), q7 = bf_hi(w.w);
                    s1[i] += ((q0 + q1) + (q2 + q3)) + ((q4 + q5) + (q6 + q7)); s2[i] += ((q0 * q0 + q1 * q1) + (q2 * q2 + q3 * q3)) + ((q4 * q4 + q5 * q5) + (q6 * q6 + q7 * q7)); } }
            asm volatile("" ::: "memory"); }
        if (MODE != 3) {
#pragma unroll
            for (int i = 0; i < 8; ++i) { float a1 = s1[i], a2 = s2[i]; a1 += __shfl_xor(a1, 16); a1 += __shfl_xor(a1, 32); a2 += __shfl_xor(a2, 16); a2 += __shfl_xor(a2, 32);
                const int row = row0 + (i >> 2) * HALF + (i & 3) * 16;
                if (fq < 2) atomicAdd(st_out + 2 * (size_t)row + fq, fq == 0 ? a1 : a2); }
        }
    }
};
struct EpiUp {
    static constexpr bool PERM = true;
    bf16_t* O; const float* st_in; const float* uu; const float* vv;
    __device__ __forceinline__ void operator()(const f32x4 (&acc)[2][2][4][2], const Unit& u, int wr, int wc, int fr, int fq) const {
        const int row0 = u.pm * BM + wr * 64 + fr, col0 = u.pn * BM + wc * 32 + 8 * fq;
        float mu[8], rstd[8];
#pragma unroll
        for (int i = 0; i < 8; ++i) ln_row_stats(st_in, row0 + (i >> 2) * HALF + (i & 3) * 16, mu[i], rstd[i]);
#pragma unroll
        for (int bj = 0; bj < 2; ++bj) { const int cc = col0 + bj * HALF;
            const f32x4 u0 = *(const f32x4*)(uu + cc), u1 = *(const f32x4*)(uu + cc + 4), w0 = *(const f32x4*)(vv + cc), w1 = *(const f32x4*)(vv + cc + 4);
#pragma unroll
            for (int i = 0; i < 8; ++i) { const int ai = i >> 2, m = i & 3;
                const float mr = mu[i] * rstd[i];
                f32x4 v0 = acc[ai][bj][m][0] * rstd[i] + (w0 - u0 * mr), v1 = acc[ai][bj][m][1] * rstd[i] + (w1 - u1 * mr);
#pragma unroll
                for (int j = 0; j < 4; ++j) { const float a = fmaxf(v0[j], 0.f), b = fmaxf(v1[j], 0.f); v0[j] = a * a; v1[j] = b * b; }
                u32x4 w; w.x = cvt_pk_bf16(v0[0], v0[1]); w.y = cvt_pk_bf16(v0[2], v0[3]); w.z = cvt_pk_bf16(v1[0], v1[1]); w.w = cvt_pk_bf16(v1[2], v1[3]);
                *(u32x4*)(O + (size_t)(row0 + ai * HALF + m * 16) * DFF + cc) = w; }
            asm volatile("" ::: "memory"); }
    }
};

template <class Epi>
__device__ __forceinline__ void gemm_phase(LAS unsigned char* lds, const Gemm g, const StaticOrder& S, const Epi& E) {
    const int tid = launder((int)threadIdx.x), wid = __builtin_amdgcn_readfirstlane(tid >> 6), lane = tid & 63, wr = wid >> 2, wc = wid & 3, fr = lane & 15, fq = lane >> 4;
    int nt = g.K / BK; asm volatile("" : "+s"(nt));
    unsigned voffA[2], voffB[2];
#pragma unroll
    for (int i = 0; i < 2; ++i) { int R, C; stage_rc(tid * 16 + i * 8192, R, C); const int Rb = Epi::PERM ? ((R & ~31) + perm32(R & 31)) : R;
        voffA[i] = (unsigned)(R * g.lda + C) * 2u; voffB[i] = (unsigned)(Rb * g.ldb + C) * 2u; }
    const size_t kstep = (size_t)(BK * 2);
    const size_t hstepA = (size_t)HALF * g.lda * 2, hstepB = (size_t)HALF * g.ldb * 2;
    const unsigned ldsw = (unsigned)wid * 1024u;
    const int aoff = lds_byte(wr * 64 + fr, fq * 8), boff = lds_byte(wc * 32 + fr, fq * 8);
#define PG8_APTR(u) ((const char*)g.A + (size_t)(u).pm * 2 * hstepA + (size_t)((u).pn / g.tpg) * (size_t)g.goff * 2)
#define PG8_BPTR(u) ((const char*)g.Bt + (size_t)(u).pn * 2 * hstepB)
#define PG8_SA(b, h) (((b) * 2 + (h)) * HTB)
#define PG8_SB(b, h) ((4 + (b) * 2 + (h)) * HTB)
#define PG8_STAGE(bufoff, gbase, voff) do { _Pragma("unroll") for (int _i = 0; _i < 2; ++_i) \
        __builtin_amdgcn_global_load_lds((const unsigned*)((const char*)(gbase) + (voff)[_i]), (LAS unsigned*)(lds + (bufoff) + ldsw + _i * 8192), 16, 0, 0); } while (0)
#define PG8_LDA(dst, b, h) do { _Pragma("unroll") for (int m = 0; m < 4; ++m) _Pragma("unroll") for (int k = 0; k < 2; ++k) dst[m][k] = *(const LAS bf16x8*)(lds + PG8_SA(b, h) + aoff + m * 2048 + k * 1024); } while (0)
#define PG8_LDB(dst, b, h) do { _Pragma("unroll") for (int n = 0; n < 2; ++n) _Pragma("unroll") for (int k = 0; k < 2; ++k) dst[n][k] = *(const LAS bf16x8*)(lds + PG8_SB(b, h) + boff + n * 2048 + k * 1024); } while (0)
#define PG8_MMA(ai, bj, At, Bt) do { __builtin_amdgcn_s_setprio(1); _Pragma("unroll") for (int m = 0; m < 4; ++m) _Pragma("unroll") for (int n = 0; n < 2; ++n) _Pragma("unroll") for (int k = 0; k < 2; ++k) \
        acc[ai][bj][m][n] = __builtin_amdgcn_mfma_f32_16x16x32_bf16(Bt[n][k], At[m][k], acc[ai][bj][m][n], 0, 0, 0); __builtin_amdgcn_s_setprio(0); } while (0)
#define PG8_WAIT_V(n) asm volatile("s_waitcnt vmcnt(" #n ")" ::: "memory")
#define PG8_WAIT_L(n) asm volatile("s_waitcnt lgkmcnt(" #n ")" ::: "memory")
#define PG8_BAR __builtin_amdgcn_s_barrier()
#define PG8_SCHED __builtin_amdgcn_sched_barrier(0)
    Unit cur, nxt; int ui = 0;
    if (!S.next(0, cur)) return;
    f32x4 acc[2][2][4][2];
#pragma unroll
    for (int a = 0; a < 2; ++a)
#pragma unroll
        for (int b = 0; b < 2; ++b)
#pragma unroll
            for (int m = 0; m < 4; ++m)
#pragma unroll
                for (int n = 0; n < 2; ++n) acc[a][b][m][n] = (f32x4){0.f, 0.f, 0.f, 0.f};
    bf16x8 At[4][2], B0[2][2], B1[2][2];
    const char* cA = PG8_APTR(cur); const char* cB = PG8_BPTR(cur);
    PG8_STAGE(PG8_SB(0, 0), cB, voffB); PG8_STAGE(PG8_SB(0, 1), cB + hstepB, voffB); PG8_STAGE(PG8_SA(0, 0), cA, voffA); PG8_STAGE(PG8_SA(0, 1), cA + hstepA, voffA);
    if (wr == 1) PG8_BAR;
    PG8_WAIT_V(2); PG8_BAR;
    PG8_STAGE(PG8_SB(1, 0), cB + kstep, voffB); PG8_STAGE(PG8_SA(1, 0), cA + kstep, voffA); PG8_STAGE(PG8_SB(1, 1), cB + hstepB + kstep, voffB);
    PG8_WAIT_V(6); PG8_BAR;
    for (;;) {
        const bool has_next = S.next(ui + 1, nxt);
        const char* nA = has_next ? PG8_APTR(nxt) : cA; const char* nB = has_next ? PG8_BPTR(nxt) : cB;
        for (int t = 0; t < nt; t += 2) {
            const bool last = (t == nt - 2);
            const char* a1 = cA + (size_t)(t + 1) * kstep;
            const char* a2 = last ? nA : cA + (size_t)(t + 2) * kstep; const char* b2 = last ? nB : cB + (size_t)(t + 2) * kstep;
            const char* a3 = a2 + kstep; const char* b3 = b2 + kstep;
            PG8_LDB(B0, 0, 0); PG8_LDB(B1, 0, 1); PG8_SCHED; PG8_LDA(At, 0, 0); PG8_STAGE(PG8_SA(1, 1), a1 + hstepA, voffA);
            PG8_WAIT_V(8); PG8_WAIT_L(0); PG8_BAR; PG8_MMA(0, 0, At, B0); PG8_MMA(0, 1, At, B1); PG8_BAR; PG8_SCHED;
            PG8_LDA(At, 0, 1); PG8_STAGE(PG8_SB(0, 0), b2, voffB); PG8_STAGE(PG8_SB(0, 1), b2 + hstepB, voffB); PG8_STAGE(PG8_SA(0, 0), a2, voffA);
            PG8_WAIT_V(8); PG8_WAIT_L(0); PG8_BAR; PG8_MMA(1, 0, At, B0); PG8_MMA(1, 1, At, B1); PG8_BAR; PG8_SCHED;
            PG8_LDB(B0, 1, 0); PG8_LDB(B1, 1, 1); PG8_SCHED; PG8_LDA(At, 1, 0); PG8_STAGE(PG8_SA(0, 1), a2 + hstepA, voffA);
            PG8_WAIT_V(8); PG8_WAIT_L(0); PG8_BAR; PG8_MMA(0, 0, At, B0); PG8_MMA(0, 1, At, B1); PG8_BAR; PG8_SCHED;
            PG8_LDA(At, 1, 1); PG8_STAGE(PG8_SB(1, 0), b3, voffB); PG8_STAGE(PG8_SB(1, 1), b3 + hstepB, voffB); PG8_STAGE(PG8_SA(1, 0), a3, voffA);
            PG8_WAIT_V(8); PG8_WAIT_L(0); PG8_BAR; PG8_MMA(1, 0, At, B0); PG8_MMA(1, 1, At, B1); PG8_BAR; PG8_SCHED;
        }
        if (wr == 0) PG8_BAR;
        asm volatile("s_nop 15\n\ts_nop 15" ::: "memory");
        E(acc, cur, wr, wc, fr, fq);
        if (!has_next) break;
#pragma unroll
        for (int a = 0; a < 2; ++a)
#pragma unroll
            for (int b = 0; b < 2; ++b)
#pragma unroll
                for (int m = 0; m < 4; ++m)
#pragma unroll
                    for (int n = 0; n < 2; ++n) acc[a][b][m][n] = (f32x4){0.f, 0.f, 0.f, 0.f};
        cur = nxt; cA = nA; cB = nB; ++ui;
        if (wr == 1) PG8_BAR;
    }
    PG8_WAIT_V(0);
    PG8_BAR;
#undef PG8_APTR
#undef PG8_BPTR
#undef PG8_SA
#undef PG8_SB
#undef PG8_STAGE
#undef PG8_LDA
#undef PG8_LDB
#undef PG8_MMA
#undef PG8_WAIT_V
#undef PG8_WAIT_L
#undef PG8_BAR
#undef PG8_SCHED
}
}

struct Args {
    const float* x; const float* p; const float* pool_w; const float* pool_scale; const float* ssm_in_w; const float* conv_w; const float* conv_b;
    const float* dt_bias; const float* a_log; const float* d_skip; const float* norm_w; const float* out_w; const float* w1; const float* w2;
    const float* ln_g; const float* ln_b; const float* ple_w; const float* gate_w;
    float* out; unsigned char* ws;
};

typedef __attribute__((address_space(4))) const Args CArgs;
__device__ __forceinline__ CArgs* kargs() { CArgs* p = (CArgs*)__builtin_amdgcn_kernarg_segment_ptr(); asm volatile("" : "+s"(p)); return p; }
#define KA(f) (kargs()->f)

__device__ __forceinline__ void transpose_item(const float* __restrict__ W, int K, int N, bf16_t* __restrict__ WT, int row_off, LAS float* scr, int item, int lane,
                                               const float* __restrict__ gk, const float* __restrict__ bk, float* uo, float* vo) {
    const int nblk = N / 32, kb = item / nblk, nb = item % nblk, k0 = 64 * kb, n0 = 32 * nb, hi = lane >> 5;
    const float* src = W + (size_t)(k0 + hi) * N + n0 + (lane & 31);
    float w[32];
#pragma unroll
    for (int i = 0; i < 32; ++i) w[i] = src[(size_t)(2 * i) * N];
    if (gk) {
        const float gl = gk[k0 + lane], bl = bk ? bk[k0 + lane] : 0.f; float pu = 0.f, pv = 0.f;
#pragma unroll
        for (int i = 0; i < 32; ++i) { const float g0 = rdlane(gl, 2 * i), g1 = rdlane(gl, 2 * i + 1), b0 = rdlane(bl, 2 * i), b1 = rdlane(bl, 2 * i + 1);
            pv += w[i] * (hi ? b1 : b0); w[i] *= (hi ? g1 : g0); pu += bf_lo(cvt_pk_bf16(w[i], 0.f)); }
        if (uo) { pu += __shfl_xor(pu, 32); pv += __shfl_xor(pv, 32);
            atomicAdd((lane < 32 ? uo : vo) + n0 + (lane & 31), lane < 32 ? pu : pv); }
    }
#pragma unroll
    for (int i = 0; i < 32; ++i) scr[(2 * i + hi) * 33 + (lane & 31)] = w[i];
    LDS_WAIT();
    const int c = lane & 7;
#pragma unroll
    for (int j = 0; j < 4; ++j) { const int n = (lane >> 3) + 8 * j; const LAS float* sp = scr + (8 * c) * 33 + n;
        u32x4 o; o.x = cvt_pk_bf16(sp[0 * 33], sp[1 * 33]); o.y = cvt_pk_bf16(sp[2 * 33], sp[3 * 33]); o.z = cvt_pk_bf16(sp[4 * 33], sp[5 * 33]); o.w = cvt_pk_bf16(sp[6 * 33], sp[7 * 33]);
        *(u32x4*)(WT + (size_t)(row_off + n0 + n) * K + k0 + 8 * c) = o; }
    LDS_WAIT();
}
__device__ __forceinline__ void transpose_matrix(const float* W, int K, int N, bf16_t* WT, int row_off, LAS float* scr, int gw, int ngw, int lane,
                                                 const float* gk = nullptr, const float* bk = nullptr, float* uo = nullptr, float* vo = nullptr) {
    const int nitems = (K / 64) * (N / 32);
    for (int it = gw; it < nitems; it += ngw) transpose_item(W, K, N, WT, row_off, scr, it, lane, gk, bk, uo, vo);
}
__device__ __forceinline__ void cvt_rows(const float* src, bf16_t* dst, size_t n4, size_t gt, size_t ngt) {
    for (size_t i = gt; i < n4; i += ngt) { const f32x4 v = ((const f32x4*)src)[i]; u32x2 w; w.x = cvt_pk_bf16(v[0], v[1]); w.y = cvt_pk_bf16(v[2], v[3]); ((u32x2*)dst)[i] = w; }
}
template <int WIN> __device__ __forceinline__ void pool_item(const f32x4* __restrict__ xp, u32x2* __restrict__ op, int t0) {
    constexpr int NR = WIN - 1 + 16;
    f32x4 a[NR], orig[16];
#pragma unroll
    for (int i = 0; i < NR; ++i) { const int t = t0 - (WIN - 1) + i; a[i] = (t >= 0) ? xp[(size_t)t * 512] : (f32x4){0.f, 0.f, 0.f, 0.f}; }
#pragma unroll
    for (int r = 0; r < 16; ++r) orig[r] = a[WIN - 1 + r];
#pragma unroll
    for (int step = 1; step < WIN; step <<= 1)
#pragma unroll
        for (int i = NR - 1; i >= step; --i) a[i] += a[i - step];
#pragma unroll
    for (int r = 0; r < 16; ++r) { const int t = t0 + r; const float inv = 1.0f / (float)((t + 1) < WIN ? (t + 1) : WIN);
        const f32x4 o = a[WIN - 1 + r] * inv - orig[r];
        u32x2 w; w.x = cvt_pk_bf16(o[0], o[1]); w.y = cvt_pk_bf16(o[2], o[3]); op[(size_t)t * 512] = w; }
}
__device__ __forceinline__ void pool_phase(const float* x, bf16_t* PB, int gt, int ngt) {
    for (int it = gt; it < NB * 128 * 512; it += ngt) {
        const int c4 = it & 511, seg = (it >> 9) & 127, b = it >> 16, gi = __builtin_amdgcn_readfirstlane(c4 >> 7);
        const f32x4* xp = (const f32x4*)(x + (size_t)b * SEQL * DM) + c4;
        u32x2* op = (u32x2*)(PB + (size_t)b * SEQL * DM) + c4;
        if (gi == 0) pool_item<2>(xp, op, seg * 16); else if (gi == 1) pool_item<4>(xp, op, seg * 16); else if (gi == 2) pool_item<8>(xp, op, seg * 16); else pool_item<16>(xp, op, seg * 16);
    }
}

__device__ __forceinline__ void dt_phase(const bf16_t* X, const bf16_t* WT, const float* dt_bias, float* DTo, int row_lo, int ntask) {
    const int tid = launder((int)threadIdx.x), wid = __builtin_amdgcn_readfirstlane(tid >> 6), lane = tid & 63, fr = lane & 15, fq = lane >> 4;
    for (int task = blockIdx.x * 8 + wid; task < ntask; task += gridDim.x * 8) {
        const int r0 = row_lo + (task >> 1) * 16, n0 = (task & 1) * 32;
        const bf16_t* xa = X + (size_t)(r0 + fr) * DM + fq * 8;
        const bf16_t* wb = WT + (size_t)(ZXW + n0 + fr) * DM + fq * 8;
        f32x4 a0 = (f32x4){0.f, 0.f, 0.f, 0.f}, a1 = (f32x4){0.f, 0.f, 0.f, 0.f};
#pragma unroll 8
        for (int k = 0; k < DM; k += 32) {
            const bf16x8 xf = *(const bf16x8*)(xa + k), w0 = *(const bf16x8*)(wb + k), w1 = *(const bf16x8*)(wb + (size_t)16 * DM + k);
            a0 = __builtin_amdgcn_mfma_f32_16x16x32_bf16(w0, xf, a0, 0, 0, 0); a1 = __builtin_amdgcn_mfma_f32_16x16x32_bf16(w1, xf, a1, 0, 0, 0);
        }
        const f32x4 b0 = *(const f32x4*)(dt_bias + n0 + 4 * fq), b1 = *(const f32x4*)(dt_bias + n0 + 16 + 4 * fq);
        f32x4 v0 = a0 + b0, v1 = a1 + b1;
#pragma unroll
        for (int j = 0; j < 4; ++j) { v0[j] = v0[j] > 20.f ? v0[j] : log1pf(__expf(v0[j])); v1[j] = v1[j] > 20.f ? v1[j] : log1pf(__expf(v1[j])); }
        float* o = DTo + (size_t)(r0 + fr) * 64 + n0 + 4 * fq;
        *(f32x4*)o = v0; *(f32x4*)(o + 16) = v1;
    }
}

#define UNPK(dst, SRC_) do { dst[0] = bf_lo((SRC_).x); dst[1] = bf_hi((SRC_).x); dst[2] = bf_lo((SRC_).y); dst[3] = bf_hi((SRC_).y); dst[4] = bf_lo((SRC_).z); dst[5] = bf_hi((SRC_).z); dst[6] = bf_lo((SRC_).w); dst[7] = bf_hi((SRC_).w); } while (0)
__device__ __forceinline__ void conv_phase(bf16_t* zx, const bf16_t* HALO, const float* conv_w, const float* conv_b) {
    const int tid = launder((int)threadIdx.x), seg = tid >> 6, cgi = tid & 63;
    for (int item = blockIdx.x; item < 128 * 12; item += gridDim.x) {
        const int bc = item / 12, ch = (item % 12) * 512 + cgi * 8;
        bf16_t* base = zx + ((size_t)bc * CHUNKL + seg * 16) * ZXW + DIN + ch;
        u32x4 hal[3], raw[16];
#pragma unroll
        for (int r = 0; r < 3; ++r) {
            if (seg == 0) hal[r] = ((bc & 15) == 0) ? (u32x4){0u, 0u, 0u, 0u} : *(const u32x4*)(HALO + ((size_t)(bc - 1) * 3 + r) * CONVD + ch);
            else hal[r] = *(const u32x4*)(base + (ptrdiff_t)(r - 3) * ZXW);
        }
#pragma unroll
        for (int r = 0; r < 16; ++r) raw[r] = *(const u32x4*)(base + (size_t)r * ZXW);
        float cw[4][8], cb[8];
#pragma unroll
        for (int k = 0; k < 4; ++k) { const f32x4 w0 = *(const f32x4*)(conv_w + k * CONVD + ch), w1 = *(const f32x4*)(conv_w + k * CONVD + ch + 4);
#pragma unroll
            for (int i = 0; i < 4; ++i) { cw[k][i] = w0[i]; cw[k][4 + i] = w1[i]; } }
        { const f32x4 b0 = *(const f32x4*)(conv_b + ch), b1 = *(const f32x4*)(conv_b + ch + 4);
#pragma unroll
          for (int i = 0; i < 4; ++i) { cb[i] = b0[i]; cb[4 + i] = b1[i]; } }
        asm volatile("s_waitcnt vmcnt(0)" ::: "memory");
        __syncthreads();
        float u0[8], u1[8], u2[8];
        UNPK(u0, hal[0]); UNPK(u1, hal[1]); UNPK(u2, hal[2]);
#pragma unroll
        for (int r = 0; r < 16; ++r) {
            float cu[8], v[8]; UNPK(cu, raw[r]);
#pragma unroll
            for (int i = 0; i < 8; ++i) { const float a = cb[i] + cw[0][i] * u0[i] + cw[1][i] * u1[i] + cw[2][i] * u2[i] + cw[3][i] * cu[i]; v[i] = fast_silu(a); u0[i] = u1[i]; u1[i] = u2[i]; u2[i] = cu[i]; }
            u32x4 w; w.x = cvt_pk_bf16(v[0], v[1]); w.y = cvt_pk_bf16(v[2], v[3]); w.z = cvt_pk_bf16(v[4], v[5]); w.w = cvt_pk_bf16(v[6], v[7]);
            *(u32x4*)(base + (size_t)r * ZXW) = w;
        }
    }
}

constexpr int SST = 272;
constexpr int L_SC = 0, L_SB = 34816, L_SM = 69632, L_SXT = 104448, L_SST = 121856, L_SX = 139264, SXS = 144, L_ACS = 157696, L_SSD_END = 158208;
static_assert(L_SSD_END <= LDS_BYTES, "SSD LDS map");

__device__ __forceinline__ void ssd_phase(LAS unsigned char* lds, bf16_t* zx, const float* DTp, const float* a_log,
                                          const float* d_skip, const float* norm_w, float* ssq) {
    const int tid = launder((int)threadIdx.x), wid = __builtin_amdgcn_readfirstlane(tid >> 6), lane = tid & 63, fr = lane & 15, fq = lane >> 4;
    const int bx = blockIdx.x, xcd = bx & 7, slot = bx >> 3;
    LAS float* sAcs = (LAS float*)(lds + L_ACS);
    for (int round = 0; round < 2; ++round) {
        int b, h;
        if (gridDim.x == 256) { const int q = ((slot >> 3) + 4 * round) * 8 + xcd; b = q >> 3; h = (q & 7) * 8 + (slot & 7); }
        else { const int item = bx + round * (int)gridDim.x; if (item >= NB * NHEAD) break; b = item >> 6; h = item & 63; }
        const int g = h >> 3;
        const float a_h = -__expf(a_log[h]), d_h = d_skip[h];
        f32x4 st[4];
#pragma unroll
        for (int i = 0; i < 4; ++i) st[i] = (f32x4){0.f, 0.f, 0.f, 0.f};
        __syncthreads();
        for (int i = tid; i < 64 * SST / 4; i += 512) ((LAS unsigned*)(lds + L_SST))[i] = 0u;
        const bf16_t* xsrc = zx + ((size_t)b * SEQL) * ZXW + DIN;
        u32x4 pf[10]; float pdt[2], sdt[2];
#define SSD_PREFETCH(cc) do { \
        _Pragma("unroll") for (int i = 0; i < 2; ++i) { const int q = tid + 512 * i, l = q & 127, pc = q >> 7; \
            pf[i] = *(const u32x4*)(xsrc + (size_t)((cc) * CHUNKL + l) * ZXW + h * 64 + pc * 8); pdt[i] = DTp[((size_t)b * SEQL + (cc) * CHUNKL + l) * 64 + h]; } \
        _Pragma("unroll") for (int i = 2; i < 6; ++i) { const int q = tid + 512 * i - 1024, l = q >> 4, pc = q & 15; \
            pf[i] = *(const u32x4*)(xsrc + (size_t)((cc) * CHUNKL + l) * ZXW + DIN + g * 128 + pc * 8); } \
        _Pragma("unroll") for (int i = 6; i < 10; ++i) { const int q = tid + 512 * i - 3072, l = q >> 4, pc = q & 15; \
            pf[i] = *(const u32x4*)(xsrc + (size_t)((cc) * CHUNKL + l) * ZXW + DIN + NGRP * DSTATE + g * 128 + pc * 8); } \
        if (wid == 7) { const size_t r0 = (size_t)b * SEQL + (cc) * CHUNKL + 2 * lane; sdt[0] = DTp[r0 * 64 + h]; sdt[1] = DTp[(r0 + 1) * 64 + h]; } } while (0)
        SSD_PREFETCH(0);
        u32x4 zn[2];
#define SSD_ZPREF(cc) do { const bf16_t* zq = zx + ((size_t)b * SEQL + (cc) * CHUNKL + wid * 16 + fr) * ZXW + h * 64 + 8 * fq; zn[0] = *(const u32x4*)zq; zn[1] = *(const u32x4*)(zq + 32); } while (0)
        SSD_ZPREF(0);
        const int l0 = wid * 16, kbmax = wid >> 1;
        for (int c = 0; c < NCHUNK; ++c) {
            __syncthreads();
#pragma unroll
            for (int i = 0; i < 2; ++i) { const int q = tid + 512 * i, l = q & 127, pc = q >> 7;
                *(LAS u32x4*)(lds + L_SX + l * SXS + pc * 16) = pf[i];
                float v[8]; UNPK(v, pf[i]); const float d = pdt[i];
#pragma unroll
                for (int j = 0; j < 8; j += 2) { const unsigned pk = cvt_pk_bf16(v[j] * d, v[j + 1] * d);
                    *(LAS unsigned short*)(lds + L_SXT + (pc * 8 + j) * SST + l * 2) = (unsigned short)(pk & 0xffffu);
                    *(LAS unsigned short*)(lds + L_SXT + (pc * 8 + j + 1) * SST + l * 2) = (unsigned short)(pk >> 16); } }
#pragma unroll
            for (int i = 2; i < 6; ++i) { const int q = tid + 512 * i - 1024, l = q >> 4, pc = q & 15; *(LAS u32x4*)(lds + L_SB + l * SST + pc * 16) = pf[i]; }
#pragma unroll
            for (int i = 6; i < 10; ++i) { const int q = tid + 512 * i - 3072, l = q >> 4, pc = q & 15; *(LAS u32x4*)(lds + L_SC + l * SST + pc * 16) = pf[i]; }
            if (wid == 7) {
                const float da0 = sdt[0] * a_h, da1 = sdt[1] * a_h;
                float s = da0 + da1;
#pragma unroll
                for (int o = 1; o < 64; o <<= 1) { const float t = __shfl_up(s, o); if (lane >= o) s += t; }
                sAcs[2 * lane] = s - da1; sAcs[2 * lane + 1] = s;
            }
            __syncthreads();
            const int l = l0 + fr;
            const size_t row = (size_t)b * SEQL + c * CHUNKL + l;
            bf16_t* zp = zx + row * ZXW + h * 64 + 8 * fq;
            u32x4 zr[2]; zr[0] = zn[0]; zr[1] = zn[1];
#define SSD_PR(pt) (32 * ((pt) >> 1) + 8 * (fr >> 2) + 4 * ((pt) & 1) + (fr & 3))
            if (c + 1 < NCHUNK) SSD_PREFETCH(c + 1);
            const float acs_end = sAcs[CHUNKL - 1];
#pragma unroll
            for (int i = 0; i < 4; ++i) { const int item = tid + 512 * i, ll = item & 127, ng = item >> 7;
                const float dec = __expf(acs_end - sAcs[ll]);
                const u32x4 w = *(const LAS u32x4*)(lds + L_SB + ll * SST + ng * 16);
                float v[8]; UNPK(v, w);
#pragma unroll
                for (int j = 0; j < 8; j += 2) { const unsigned pk = cvt_pk_bf16(v[j] * dec, v[j + 1] * dec);
                    *(LAS unsigned short*)(lds + L_SM + (ng * 8 + j) * SST + ll * 2) = (unsigned short)(pk & 0xffffu);
                    *(LAS unsigned short*)(lds + L_SM + (ng * 8 + j + 1) * SST + ll * 2) = (unsigned short)(pk >> 16); } }
            {
                bf16x8 yc[4];
#pragma unroll
                for (int kb = 0; kb < 4; ++kb) yc[kb] = *(const LAS bf16x8*)(lds + L_SC + (l0 + fr) * SST + kb * 64 + fq * 16);
                const float acs_l = sAcs[l];
                f32x4 yd[4], yo[4];
#pragma unroll
                for (int i = 0; i < 4; ++i) { yd[i] = (f32x4){0.f, 0.f, 0.f, 0.f}; yo[i] = (f32x4){0.f, 0.f, 0.f, 0.f}; }
                for (int kp = 0; kp <= kbmax; ++kp) {
                    const int t0 = 2 * kp, t1 = 2 * kp + 1; const bool do1 = (t1 <= wid);
                    bf16x8 xb0[4], xb1[4]; u32x2 x0[4], x1[4];
#pragma unroll
                    for (int kb = 0; kb < 4; ++kb) { xb0[kb] = *(const LAS bf16x8*)(lds + L_SB + (t0 * 16 + fr) * SST + kb * 64 + fq * 16);
                        xb1[kb] = *(const LAS bf16x8*)(lds + L_SB + (t1 * 16 + fr) * SST + kb * 64 + fq * 16); }
                    const f32x4 as0 = *(const LAS f32x4*)(lds + L_ACS + (t0 * 16 + 4 * fq) * 4), as1 = *(const LAS f32x4*)(lds + L_ACS + (t1 * 16 + 4 * fq) * 4);
                    f32x4 a0 = (f32x4){0.f, 0.f, 0.f, 0.f}, a1 = (f32x4){0.f, 0.f, 0.f, 0.f};
#pragma unroll
                    for (int kb = 0; kb < 4; ++kb) { a0 = __builtin_amdgcn_mfma_f32_16x16x32_bf16(xb0[kb], yc[kb], a0, 0, 0, 0); a1 = __builtin_amdgcn_mfma_f32_16x16x32_bf16(xb1[kb], yc[kb], a1, 0, 0, 0); }
#pragma unroll
                    for (int pt = 0; pt < 4; ++pt) { x0[pt] = *(const LAS u32x2*)(lds + L_SXT + SSD_PR(pt) * SST + (kp * 32 + 4 * fq) * 2);
                        x1[pt] = *(const LAS u32x2*)(lds + L_SXT + SSD_PR(pt) * SST + (kp * 32 + 16 + 4 * fq) * 2); }
#pragma unroll
                    for (int r = 0; r < 4; ++r) { const int s0 = t0 * 16 + 4 * fq + r, s1 = t1 * 16 + 4 * fq + r;
                        a0[r] = (s0 <= l) ? a0[r] * __expf(acs_l - as0[r]) : 0.f; a1[r] = (do1 && s1 <= l) ? a1[r] * __expf(acs_l - as1[r]) : 0.f; }
                    u32x4 mw; mw.x = cvt_pk_bf16(a0[0], a0[1]); mw.y = cvt_pk_bf16(a0[2], a0[3]); mw.z = cvt_pk_bf16(a1[0], a1[1]); mw.w = cvt_pk_bf16(a1[2], a1[3]);
                    asm volatile("s_nop 1" : "+v"(mw));
                    bf16x8 ym; __builtin_memcpy(&ym, &mw, 16);
#pragma unroll
                    for (int pt = 0; pt < 4; ++pt) { u32x4 xw; xw.x = x0[pt].x; xw.y = x0[pt].y; xw.z = x1[pt].x; xw.w = x1[pt].y;
                        bf16x8 xx; __builtin_memcpy(&xx, &xw, 16);
                        yd[pt] = __builtin_amdgcn_mfma_f32_16x16x32_bf16(xx, ym, yd[pt], 0, 0, 0); }
                }
#pragma unroll
                for (int kh = 0; kh < 2; ++kh) {
                    bf16x8 sfr[2][4];
#pragma unroll
                    for (int k2 = 0; k2 < 2; ++k2)
#pragma unroll
                        for (int pt = 0; pt < 4; ++pt) sfr[k2][pt] = *(const LAS bf16x8*)(lds + L_SST + SSD_PR(pt) * SST + (kh * 2 + k2) * 64 + fq * 16);
#pragma unroll
                    for (int k2 = 0; k2 < 2; ++k2)
#pragma unroll
                        for (int pt = 0; pt < 4; ++pt) yo[pt] = __builtin_amdgcn_mfma_f32_16x16x32_bf16(sfr[k2][pt], yc[kh * 2 + k2], yo[pt], 0, 0, 0);
                }
                const float el = __expf(acs_l);
                float sq = 0.f;
#pragma unroll
                for (int a2 = 0; a2 < 2; ++a2) {
                    const u32x4 xw = *(const LAS u32x4*)(lds + L_SX + l * SXS + (a2 * 32 + 8 * fq) * 2);
                    const u32x4 zw = zr[a2];
                    const f32x4 ya = yd[2 * a2] + yo[2 * a2] * el, yb = yd[2 * a2 + 1] + yo[2 * a2 + 1] * el;
                    float y0 = ya[0] + d_h * bf_lo(xw.x), y1 = ya[1] + d_h * bf_hi(xw.x), y2 = ya[2] + d_h * bf_lo(xw.y), y3 = ya[3] + d_h * bf_hi(xw.y);
                    float y4 = yb[0] + d_h * bf_lo(xw.z), y5 = yb[1] + d_h * bf_hi(xw.z), y6 = yb[2] + d_h * bf_lo(xw.w), y7 = yb[3] + d_h * bf_hi(xw.w);
                    y0 *= fast_silu(bf_lo(zw.x)); y1 *= fast_silu(bf_hi(zw.x)); y2 *= fast_silu(bf_lo(zw.y)); y3 *= fast_silu(bf_hi(zw.y));
                    y4 *= fast_silu(bf_lo(zw.z)); y5 *= fast_silu(bf_hi(zw.z)); y6 *= fast_silu(bf_lo(zw.w)); y7 *= fast_silu(bf_hi(zw.w));
                    sq += ((y0 * y0 + y1 * y1) + (y2 * y2 + y3 * y3)) + ((y4 * y4 + y5 * y5) + (y6 * y6 + y7 * y7));
                    u32x4 w; w.x = cvt_pk_bf16(y0, y1); w.y = cvt_pk_bf16(y2, y3); w.z = cvt_pk_bf16(y4, y5); w.w = cvt_pk_bf16(y6, y7);
                    *(u32x4*)(zp + a2 * 32) = w;
                }
                sq += __shfl_xor(sq, 16); sq += __shfl_xor(sq, 32);
                if (fq == 0) atomicAdd(ssq + row, sq);
                if (c + 1 < NCHUNK) SSD_ZPREF(c + 1);
            }
            __syncthreads();
            {
                const float ce = __expf(acs_end);
#pragma unroll
                for (int pt = 0; pt < 4; ++pt) st[pt] = st[pt] * ce;
#pragma unroll
                for (int kh = 0; kh < 2; ++kh) {
                    bf16x8 xb[2], yx[2][4];
#pragma unroll
                    for (int k2 = 0; k2 < 2; ++k2) { xb[k2] = *(const LAS bf16x8*)(lds + L_SM + (l0 + fr) * SST + (kh * 2 + k2) * 64 + fq * 16);
#pragma unroll
                        for (int pt = 0; pt < 4; ++pt) yx[k2][pt] = *(const LAS bf16x8*)(lds + L_SXT + (pt * 16 + fr) * SST + (kh * 2 + k2) * 64 + fq * 16); }
#pragma unroll
                    for (int k2 = 0; k2 < 2; ++k2)
#pragma unroll
                        for (int pt = 0; pt < 4; ++pt) st[pt] = __builtin_amdgcn_mfma_f32_16x16x32_bf16(xb[k2], yx[k2][pt], st[pt], 0, 0, 0);
                }
                asm volatile("s_nop 15\n\ts_nop 15" : "+v"(st[0]), "+v"(st[1]), "+v"(st[2]), "+v"(st[3]));
#pragma unroll
                for (int pt = 0; pt < 4; ++pt) { u32x2 w; w.x = cvt_pk_bf16(st[pt][0], st[pt][1]); w.y = cvt_pk_bf16(st[pt][2], st[pt][3]);
                    *(LAS u32x2*)(lds + L_SST + (pt * 16 + fr) * SST + (l0 + 4 * fq) * 2) = w; }
            }
        }
#undef SSD_PREFETCH
#undef SSD_ZPREF
#undef SSD_PR
    }
    __syncthreads();
}

__global__ void __launch_bounds__(512, 2) fwd_megakernel(Args a) {
    extern __shared__ __attribute__((aligned(16))) unsigned char lds_raw[];
    LAS unsigned char* lds = (LAS unsigned char*)lds_raw;
    cg::grid_group grid = cg::this_grid();
    const int G = gridDim.x;
    volatile LAS unsigned* barst = (volatile LAS unsigned*)(lds + L_BARST);
    if (threadIdx.x < 2) barst[threadIdx.x] = 0u;
    __syncthreads();
    xcd_barrier_post((unsigned*)(KA(ws) + WS_BAR));
    if (gridDim.x == 0x7fffffffu) grid.sync();
#define GRID_SYNC() xcd_barrier((unsigned*)(KA(ws) + WS_BAR), barst)
#define SSQ ((float*)(KA(ws) + WS_SSQ))
#define W1t ((bf16_t*)(KA(ws) + WS_W + W_W1))
#define W2t ((bf16_t*)(KA(ws) + WS_W + W_W2))
#define WGt ((bf16_t*)(KA(ws) + WS_W + W_GATE))
#define WPt ((bf16_t*)(KA(ws) + WS_W + W_PLE))
#define WAt ((bf16_t*)(KA(ws) + WS_W + W_A))
#define WOt ((bf16_t*)(KA(ws) + WS_W + W_OUT))
#define XB ((bf16_t*)(KA(ws) + WS_XB))
#define PBF ((bf16_t*)(KA(ws) + WS_PBF))
#define DT ((float*)(KA(ws) + WS_DT))
#define BIG ((bf16_t*)(KA(ws) + WS_BIG))
#define PW ((bf16_t*)(KA(ws) + WS_BIG + BIG_PW))
#define XF (KA(out))
#define XB1 ((bf16_t*)KA(out))
#define HALOB ((bf16_t*)(KA(ws) + WS_HALO))

#define ST1 ((float*)(KA(ws) + WS_ST1))
#define ST2 ((float*)(KA(ws) + WS_ST2))
#define UVP(layer, off) ((float*)(KA(ws) + WS_UV) + (layer) * UV_LAYER + (off))
    {
        const int tid = launder((int)threadIdx.x), gt = blockIdx.x * 512 + tid, ngt = launder_s(G) * 512;
        pool_phase(KA(x), BIG, gt, ngt);
        cvt_rows(KA(p), PBF, (size_t)2 * MROWS * PLED / 4, gt, ngt);
    }
#define PREPASS_VARS() const int tid = launder((int)threadIdx.x), lane = tid & 63, wave = __builtin_amdgcn_readfirstlane(tid >> 6); \
        const int gw = blockIdx.x * 8 + wave, gt = blockIdx.x * 512 + tid, ngw = launder_s(G) * 8, ngt = launder_s(G) * 512; \
        LAS float* scr = (LAS float*)(lds + wave * 16384); (void)gt; (void)ngt
#define PREPASS_MAIN(L) do { PREPASS_VARS(); \
        transpose_matrix(KA(w1) + (size_t)(L) * DM * DFF, DM, DFF, W1t, 0, scr, gw, ngw, lane, \
                         KA(ln_g) + (size_t)((L) * 2 + 0) * DM, KA(ln_b) + (size_t)((L) * 2 + 0) * DM, UVP((L), UV_U1), UVP((L), UV_V1)); \
        transpose_matrix(KA(w2) + (size_t)(L) * DFF * DM, DFF, DM, W2t, 0, scr, gw, ngw, lane); \
        if ((L) == 0) { for (int gi = 0; gi < 4; ++gi) transpose_matrix(KA(pool_w) + (size_t)gi * 512 * 512, 512, 512, WAt, gi * 512, scr, gw, ngw, lane); } \
        else { transpose_matrix(KA(ssm_in_w), DM, NIN, WAt, 0, scr, gw, ngw, lane); \
               transpose_matrix(KA(out_w), DIN, DM, WOt, 0, scr, gw, ngw, lane, KA(norm_w)); } } while (0)
#define PREPASS_LATE(L) do { PREPASS_VARS(); \
        transpose_matrix(KA(gate_w) + (size_t)(L) * DM * DM, DM, DM, WGt, 0, scr, gw, ngw, lane, \
                         KA(ln_g) + (size_t)((L) * 2 + 1) * DM, KA(ln_b) + (size_t)((L) * 2 + 1) * DM, UVP((L), UV_UG), UVP((L), UV_VG)); \
        transpose_matrix(KA(ple_w) + (size_t)(L) * PLED * DM, PLED, DM, WPt, 0, scr, gw, ngw, lane); \
        if ((L) == 1) { float* const zp = ST1; for (int i = gt; i < 4 * MROWS; i += ngt) zp[i] = 0.f; } } while (0)
    PREPASS_MAIN(0);
    PREPASS_LATE(0);
    GRID_SYNC();
    for (int layer = 0; layer < 2; ++layer) {
        if (layer == 0) {
            pg8::Gemm g{BIG, WAt, DM, 512, 512, 2, 512}; pg8::StaticOrder S; S.init(MROWS, DM, launder_s(G), launder_s((int)blockIdx.x));
            pg8::EpiRes<0> E{XF, XB, KA(x), KA(pool_scale), nullptr, nullptr, nullptr, ST1, nullptr, nullptr, nullptr, nullptr, XB, 0};
            pg8::gemm_phase(lds, g, S, E);
            GRID_SYNC();
        } else {
            PREPASS_LATE(1);
            __syncthreads();
            { pg8::Gemm g{XB1, WAt, DM, DM, DM, 1 << 20, 0}; pg8::StaticOrder S; S.init(MROWS, ZXW, launder_s(G), launder_s((int)blockIdx.x));
              pg8::EpiInProj E{BIG, DT, KA(dt_bias), HALOB};
              pg8::gemm_phase(lds, g, S, E); }
            GRID_SYNC();
            dt_phase(XB1, WAt, KA(dt_bias), DT, 0, 2 * (MROWS / 16));
            conv_phase(BIG, HALOB, KA(conv_w), KA(conv_b));
            GRID_SYNC();
            ssd_phase(lds, BIG, DT, KA(a_log), KA(d_skip), KA(norm_w), SSQ);
            GRID_SYNC();
            { pg8::Gemm g{BIG, WOt, ZXW, DIN, DIN, 1 << 20, 0}; pg8::StaticOrder S; S.init(MROWS, DM, launder_s(G), launder_s((int)blockIdx.x));
              pg8::EpiRes<2> E{XF, XB, nullptr, nullptr, SSQ, nullptr, nullptr, ST1, nullptr, nullptr, nullptr, nullptr, XB1, 0};
              pg8::gemm_phase(lds, g, S, E); }
            GRID_SYNC();
        }
        for (int step = 0; step < 3; ++step) {
            if (step > 0) {
                const int pmh = (step - 1) * (MROWS / 512);
                pg8::Gemm g{BIG, W2t, DFF, DFF, DFF, 1 << 20, 0}; pg8::StaticOrder S; S.init(MROWS / 2, DM, launder_s(G), launder_s((int)blockIdx.x), pmh);
                pg8::EpiRes<1> E{XF, XB, nullptr, nullptr, nullptr, nullptr, ST1, ST2, KA(ln_g) + (size_t)(layer * 2 + 0) * DM, KA(ln_b) + (size_t)(layer * 2 + 0) * DM, nullptr, nullptr, XB, 0};
                pg8::gemm_phase(lds, g, S, E);
            }
            if (step < 2) {
                const int pmh = step * (MROWS / 512);
                pg8::Gemm g{XB, W1t, DM, DM, DM, 1 << 20, 0}; pg8::StaticOrder S; S.init(MROWS / 2, DFF, launder_s(G), launder_s((int)blockIdx.x), pmh);
                pg8::EpiUp E{BIG, ST1, UVP(layer, UV_U1), UVP(layer, UV_V1)};
                pg8::gemm_phase(lds, g, S, E);
            }
            GRID_SYNC();
        }
        { pg8::Gemm g{PBF + (size_t)layer * MROWS * PLED, WPt, PLED, PLED, PLED, 1 << 20, 0}; pg8::StaticOrder S; S.init(MROWS, DM, launder_s(G), launder_s((int)blockIdx.x));
          pg8::EpiBf16<0> E{PW, DM};
          pg8::gemm_phase(lds, g, S, E); }
        { pg8::Gemm g{XB, WGt, DM, DM, DM, 1 << 20, 0}; pg8::StaticOrder S; S.init(MROWS, DM, launder_s(G), launder_s((int)blockIdx.x));
          pg8::EpiRes<3> E{XF, layer == 0 ? XB1 : XB, nullptr, nullptr, nullptr, PW, ST2, nullptr, KA(ln_g) + (size_t)(layer * 2 + 1) * DM, KA(ln_b) + (size_t)(layer * 2 + 1) * DM, UVP(layer, UV_UG), UVP(layer, UV_VG), XB, layer == 0 ? 1 : 0};
          pg8::gemm_phase(lds, g, S, E); }
        if (layer == 0) { PREPASS_MAIN(1); GRID_SYNC(); }
    }
}

extern "C" void kernel_launch(void* const* d_in, const int* in_sizes, int n_in, void* d_out, int out_size, void* d_ws, size_t ws_size, hipStream_t stream) {
    static int grid = 0;
    if (grid == 0) {
        if (n_in != 18 || in_sizes[0] != MROWS * DM || out_size != MROWS * DM || ws_size < WS_END) {
            fprintf(stderr, "kernel_launch: unexpected shapes (n_in %d, in0 %d, out %d, ws %zu, need %zu); nothing launched\n", n_in, n_in > 0 ? in_sizes[0] : -1, out_size, ws_size, (size_t)WS_END);
            grid = -1; return; }
        int dev = 0, cus = 0, per_cu = 0;
        if (hipGetDevice(&dev) != hipSuccess || hipDeviceGetAttribute(&cus, hipDeviceAttributeMultiprocessorCount, dev) != hipSuccess) { grid = -1; return; }
        if (hipFuncSetAttribute((const void*)fwd_megakernel, hipFuncAttributeMaxDynamicSharedMemorySize, LDS_BYTES) != hipSuccess) { fprintf(stderr, "kernel_launch: hipFuncSetAttribute failed\n"); grid = -1; return; }
        if (hipOccupancyMaxActiveBlocksPerMultiprocessor(&per_cu, (const void*)fwd_megakernel, 512, LDS_BYTES) != hipSuccess || per_cu < 1) { fprintf(stderr, "kernel_launch: occupancy query says %d blocks per CU\n", per_cu); per_cu = 1; }
        (void)hipGetLastError();
        grid = cus;
    }
    if (grid < 0) return;
    Args a{};
    a.x = (const float*)d_in[0]; a.p = (const float*)d_in[1]; a.pool_w = (const float*)d_in[2]; a.pool_scale = (const float*)d_in[3]; a.ssm_in_w = (const float*)d_in[4];
    a.conv_w = (const float*)d_in[5]; a.conv_b = (const float*)d_in[6]; a.dt_bias = (const float*)d_in[7]; a.a_log = (const float*)d_in[8]; a.d_skip = (const float*)d_in[9];
    a.norm_w = (const float*)d_in[10]; a.out_w = (const float*)d_in[11]; a.w1 = (const float*)d_in[12]; a.w2 = (const float*)d_in[13]; a.ln_g = (const float*)d_in[14];
    a.ln_b = (const float*)d_in[15]; a.ple_w = (const float*)d_in[16]; a.gate_w = (const float*)d_in[17];
    a.out = (float*)d_out; a.ws = (unsigned char*)d_ws;
    if (hipMemsetAsync(d_ws, 0, WS_W, stream) != hipSuccess) { fprintf(stderr, "kernel_launch: hipMemsetAsync failed\n"); return; }
    void* args[] = {&a};
    const hipError_t e = hipLaunchCooperativeKernel((const void*)fwd_megakernel, dim3(grid), dim3(512), args, LDS_BYTES, stream);
    if (e != hipSuccess) fprintf(stderr, "kernel_launch: cooperative launch failed: %s (grid %d)\n", hipGetErrorString(e), grid);
}
```
